# Optimizing an MI355X kernel written in HIP

```python
import jax, jax.numpy as jnp
from jax import lax
import numpy as np

D_MODEL = 4096
BATCH = 1
SEQ = 16384
DEPTH = 2

HEAD_DIM = 128
BLK = 128
EPS = 1e-5
NEG = -1e30

H_SB = 8
H_SW = 24
KV_SW = 3
SW_WINDOW = 128
AB_IN_WIDTH = 3 * H_SB * HEAD_DIM + (H_SW + 2 * KV_SW) * HEAD_DIM
AB_OUT_WIDTH = (H_SB + H_SW) * HEAD_DIM

H_NSA = 32
KV_NSA = 2
NSA_CMP_LEN = 32
NSA_CMP_STRIDE = 16
NSA_CMP_HID = 128
NSA_SEL_LEN = 64
NSA_TOP_N = 8
NSA_WINDOW = 512
NSA_FORCE = 1e4
NSA_IN_WIDTH = H_NSA * HEAD_DIM + 6 * KV_NSA * HEAD_DIM + 3 * H_NSA
NSA_OUT_WIDTH = H_NSA * HEAD_DIM

D_FF = ((8 * D_MODEL + 3 * 256 - 1) // (3 * 256)) * 256

N_EVEN = (DEPTH + 1) // 2
N_ODD = DEPTH // 2

kernel_name = "hybrid_stickbreak_swa_sink_nsa_swiglu"


def rmsnorm(x, g):
    xf = x.astype(jnp.float32)
    y = xf * lax.rsqrt(jnp.mean(xf * xf, axis=-1, keepdims=True) + EPS)
    return (y * g.astype(jnp.float32)).astype(x.dtype)


def split_cols(z, widths):
    outs, off = [], 0
    for w in widths:
        outs.append(z[..., off:off + w])
        off += w
    return outs


def alibi_slopes(n_heads, n_kv):
    s = jnp.exp2(-8.0 * jnp.arange(1, n_heads + 1, dtype=jnp.float32) / n_heads)
    return s.reshape(n_heads // n_kv, n_kv).T


def masked_softmax(s, mask):
    s = jnp.where(mask, s, NEG)
    m = jnp.max(s, axis=-1, keepdims=True)
    e = jnp.where(mask, jnp.exp(s - m), 0.0)
    return e / jnp.maximum(jnp.sum(e, axis=-1, keepdims=True), 1e-30)


def map_query_blocks(fn, q):
    B, S = q.shape[:2]
    nb = S // BLK
    qb = jnp.moveaxis(q.reshape((B, nb, BLK) + q.shape[2:]), 1, 0)
    out = lax.map(lambda a: fn(a[0], a[1]), (jnp.arange(nb), qb))
    return jnp.moveaxis(out, 0, 1).reshape((B, S) + out.shape[3:])


def stick_breaking_attention(q, k, v):
    B, S, H, d = q.shape
    nb = S // BLK
    scale = HEAD_DIM ** -0.5
    j_in = jnp.arange(BLK)
    upper = (j_in[:, None] >= j_in[None, :]).astype(jnp.float32)
    outs = []
    for i in range(nb):
        n_k = (i + 1) * BLK
        qb = q[:, i * BLK:n_k]
        kb, vb = k[:, :n_k], v[:, :n_k]
        z = jnp.einsum("bqhd,bkhd->bhqk", qb, kb).astype(jnp.float32) * scale
        t = i * BLK + jnp.arange(BLK)
        before = jnp.arange(n_k)[None, :] < t[:, None]
        a = jnp.where(before, jax.nn.log_sigmoid(-z), 0.0).reshape(B, H, BLK, i + 1, BLK)
        within = jnp.einsum("bhqnj,js->bhqns", a, upper)
        tot = jnp.sum(a, axis=-1)
        later = lax.cumsum(tot, axis=3, reverse=True) - tot
        r = (within + later[..., None]).reshape(B, H, BLK, n_k)
        w = jnp.where(before, jnp.exp(z + r), 0.0)
        outs.append(jnp.einsum("bhqk,bkhd->bqhd", w.astype(vb.dtype), vb))
    return jnp.concatenate(outs, axis=1)


def window_attention(q, k, v, window, slopes, sinks=None):
    n_prev = -(-(window - 1) // BLK)
    pad = n_prev * BLK
    span = pad + BLK
    kp = jnp.pad(k, ((0, 0), (pad, 0), (0, 0), (0, 0)))
    vp = jnp.pad(v, ((0, 0), (pad, 0), (0, 0), (0, 0)))
    scale = HEAD_DIM ** -0.5

    def block(i, qb):
        start = i * BLK
        kb = lax.dynamic_slice_in_dim(kp, start, span, axis=1)
        vb = lax.dynamic_slice_in_dim(vp, start, span, axis=1)
        t = start + jnp.arange(BLK)
        s_pos = start - pad + jnp.arange(span)
        dist = t[:, None] - s_pos[None, :]
        mask = (dist >= 0) & (dist < window) & (s_pos[None, :] >= 0)
        s = (jnp.einsum("bqhgd,bkhd->bhgqk", qb, kb).astype(jnp.float32) * scale
             - slopes[:, :, None, None] * dist.astype(jnp.float32))
        s = jnp.where(mask, s, NEG)
        if sinks is None:
            p = jax.nn.softmax(s, axis=-1)
        else:
            sink = jnp.broadcast_to(sinks.astype(jnp.float32)[None, :, :, None, None], s.shape[:-1] + (1,))
            p = jax.nn.softmax(jnp.concatenate([s, sink], axis=-1), axis=-1)[..., :-1]
        return jnp.einsum("bhgqk,bkhd->bqhgd", p.astype(vb.dtype), vb)

    return map_query_blocks(block, q)


def compress_blocks(x, pos, w1, w2):
    B, S, Hkv, d = x.shape
    chunks = x.reshape(B, S // NSA_CMP_STRIDE, NSA_CMP_STRIDE, Hkv, d)
    blocks = jnp.concatenate([chunks[:, :-1], chunks[:, 1:]], axis=2) + pos[None, None, :, None, :]
    flat = jnp.swapaxes(blocks, 2, 3).reshape(B, -1, Hkv, NSA_CMP_LEN * d)
    return jax.nn.gelu(flat @ w1) @ w2


def nsa_attention(q, k_cmp, v_cmp, k_slc, v_slc, k_win, v_win, gates, slopes):
    B, S, Hkv, G, d = q.shape
    n_cmp = k_cmp.shape[1]
    n_slc = S // NSA_SEL_LEN
    top_n = min(NSA_TOP_N, n_slc)
    r = NSA_SEL_LEN // NSA_CMP_STRIDE
    scale = HEAD_DIM ** -0.5
    cmp_end = jnp.arange(n_cmp) * NSA_CMP_STRIDE + NSA_CMP_LEN - 1
    ks_blocks = k_slc.reshape(B, n_slc, NSA_SEL_LEN, Hkv, d).transpose(0, 3, 1, 2, 4)
    vs_blocks = v_slc.reshape(B, n_slc, NSA_SEL_LEN, Hkv, d).transpose(0, 3, 1, 2, 4)
    b_idx = jnp.arange(B)[:, None, None, None]
    h_idx = jnp.arange(Hkv)[None, :, None, None]
    blk = jnp.arange(n_slc)
    tok = jnp.arange(NSA_SEL_LEN)

    def block(i, qb):
        t = i * BLK + jnp.arange(BLK)
        dist_c = (t[:, None] - cmp_end[None, :]).astype(jnp.float32)
        s_c = (jnp.einsum("bqhgd,bchd->bhgqc", qb, k_cmp).astype(jnp.float32) * scale
               - slopes[:, :, None, None] * dist_c)
        p_c = masked_softmax(s_c, dist_c >= 0)
        o_cmp = jnp.einsum("bhgqc,bchd->bqhgd", p_c.astype(v_cmp.dtype), v_cmp)
        imp = jnp.pad(jnp.sum(p_c, axis=2), ((0, 0), (0, 0), (0, 0), (1, 1)))
        imp = imp[..., :r * n_slc].reshape(B, Hkv, BLK, n_slc, r).sum(-1) + imp[..., r::r]
        cur = t // NSA_SEL_LEN
        valid = blk[None, :] <= cur[:, None]
        forced = (blk[None, :] == 0) | (blk[None, :] == cur[:, None]) | (blk[None, :] == cur[:, None] - 1)
        score = jnp.where(valid, imp + jnp.where(forced, NSA_FORCE, 0.0), NEG)
        _, idx = lax.top_k(score, top_n)
        k_sel = ks_blocks[b_idx, h_idx, idx].reshape(B, Hkv, BLK, top_n * NSA_SEL_LEN, d)
        v_sel = vs_blocks[b_idx, h_idx, idx].reshape(B, Hkv, BLK, top_n * NSA_SEL_LEN, d)
        pos_sel = (idx[..., None] * NSA_SEL_LEN + tok).reshape(B, Hkv, BLK, top_n * NSA_SEL_LEN)
        dist_s = t[None, None, :, None] - pos_sel
        s_s = (jnp.einsum("bqhgd,bhqnd->bhgqn", qb, k_sel).astype(jnp.float32) * scale
               - slopes[:, :, None, None] * dist_s[:, :, None].astype(jnp.float32))
        p_s = masked_softmax(s_s, (dist_s >= 0)[:, :, None])
        o_slc = jnp.einsum("bhgqn,bhqnd->bqhgd", p_s.astype(v_sel.dtype), v_sel)
        return jnp.stack([o_cmp, o_slc], axis=-1)

    o = map_query_blocks(block, q)
    o_win = window_attention(q, k_win, v_win, NSA_WINDOW, slopes)
    return gates[..., 0:1] * o[..., 0] + gates[..., 1:2] * o[..., 1] + gates[..., 2:3] * o_win


def ab_mixer(h, w_in, sinks, w_out):
    B, S, _ = h.shape
    d_sb, d_swq, d_swkv = H_SB * HEAD_DIM, H_SW * HEAD_DIM, KV_SW * HEAD_DIM
    q_a, k_a, v_a, q_b, k_b, v_b = split_cols(h @ w_in, [d_sb, d_sb, d_sb, d_swq, d_swkv, d_swkv])
    g_sw = H_SW // KV_SW
    o_a = stick_breaking_attention(q_a.reshape(B, S, H_SB, HEAD_DIM),
                                   k_a.reshape(B, S, H_SB, HEAD_DIM),
                                   v_a.reshape(B, S, H_SB, HEAD_DIM))
    o_b = window_attention(q_b.reshape(B, S, KV_SW, g_sw, HEAD_DIM),
                           k_b.reshape(B, S, KV_SW, HEAD_DIM),
                           v_b.reshape(B, S, KV_SW, HEAD_DIM),
                           SW_WINDOW, alibi_slopes(H_SW, KV_SW), sinks.reshape(KV_SW, g_sw))
    o = jnp.concatenate([o_a.reshape(B, S, -1), o_b.reshape(B, S, -1)], axis=-1)
    return o @ w_out


def nsa_mixer(h, w_in, cmp_pos, wk1, wk2, wv1, wv2, w_out):
    B, S, _ = h.shape
    dq, dkv = H_NSA * HEAD_DIM, KV_NSA * HEAD_DIM
    g_nsa = H_NSA // KV_NSA
    q, kc, vc, ks, vs, kw, vw, g = split_cols(h @ w_in, [dq, dkv, dkv, dkv, dkv, dkv, dkv, 3 * H_NSA])
    kv = lambda z: z.reshape(B, S, KV_NSA, HEAD_DIM)
    k_cmp = compress_blocks(kv(kc), cmp_pos, wk1, wk2)
    v_cmp = compress_blocks(kv(vc), cmp_pos, wv1, wv2)
    gates = jax.nn.sigmoid(g.reshape(B, S, KV_NSA, g_nsa, 3))
    o = nsa_attention(q.reshape(B, S, KV_NSA, g_nsa, HEAD_DIM), k_cmp, v_cmp,
                      kv(ks), kv(vs), kv(kw), kv(vw), gates, alibi_slopes(H_NSA, KV_NSA))
    return o.reshape(B, S, -1) @ w_out


def swiglu(h, w_gate_up, w_down):
    gate, up = jnp.split(h @ w_gate_up, 2, axis=-1)
    return (jax.nn.silu(gate) * up) @ w_down


def setup_inputs(seed: int = 0) -> dict:
    key = jax.random.key(seed)
    ks = jax.random.split(key, 16)
    nrm = lambda k, shape: jax.random.normal(k, shape, jnp.float32)
    w = lambda k, shape, fan_in: nrm(k, shape) * fan_in ** -0.5
    gain = lambda k, shape: 1.0 + 0.02 * nrm(k, shape)
    cmp_in = NSA_CMP_LEN * HEAD_DIM
    return {
        "x": nrm(ks[0], (BATCH, SEQ, D_MODEL)),
        "attn_norm": gain(ks[1], (DEPTH, D_MODEL)),
        "ffn_norm": gain(ks[2], (DEPTH, D_MODEL)),
        "w_gate_up": w(ks[3], (DEPTH, D_MODEL, 2 * D_FF), D_MODEL),
        "w_down": w(ks[4], (DEPTH, D_FF, D_MODEL), D_FF),
        "ab_w_in": w(ks[5], (N_EVEN, D_MODEL, AB_IN_WIDTH), D_MODEL),
        "ab_sinks": 0.5 * nrm(ks[6], (N_EVEN, H_SW)),
        "ab_w_out": w(ks[7], (N_EVEN, AB_OUT_WIDTH, D_MODEL), AB_OUT_WIDTH),
        "nsa_w_in": w(ks[8], (N_ODD, D_MODEL, NSA_IN_WIDTH), D_MODEL),
        "nsa_cmp_pos": 0.1 * nrm(ks[9], (N_ODD, NSA_CMP_LEN, HEAD_DIM)),
        "nsa_cmp_wk1": w(ks[10], (N_ODD, cmp_in, NSA_CMP_HID), cmp_in),
        "nsa_cmp_wk2": w(ks[11], (N_ODD, NSA_CMP_HID, HEAD_DIM), NSA_CMP_HID),
        "nsa_cmp_wv1": w(ks[12], (N_ODD, cmp_in, NSA_CMP_HID), cmp_in),
        "nsa_cmp_wv2": w(ks[13], (N_ODD, NSA_CMP_HID, HEAD_DIM), NSA_CMP_HID),
        "nsa_w_out": w(ks[14], (N_ODD, NSA_OUT_WIDTH, D_MODEL), NSA_OUT_WIDTH),
        "final_norm": gain(ks[15], (D_MODEL,)),
    }


def reference(x, attn_norm, ffn_norm, w_gate_up, w_down, ab_w_in, ab_sinks, ab_w_out,
              nsa_w_in, nsa_cmp_pos, nsa_cmp_wk1, nsa_cmp_wk2, nsa_cmp_wv1, nsa_cmp_wv2,
              nsa_w_out, final_norm):
    for layer in range(DEPTH):
        h = rmsnorm(x, attn_norm[layer])
        if layer % 2 == 0:
            e = layer // 2
            x = x + ab_mixer(h, ab_w_in[e], ab_sinks[e], ab_w_out[e])
        else:
            o = layer // 2
            x = x + nsa_mixer(h, nsa_w_in[o], nsa_cmp_pos[o], nsa_cmp_wk1[o], nsa_cmp_wk2[o],
                              nsa_cmp_wv1[o], nsa_cmp_wv2[o], nsa_w_out[o])
        x = x + swiglu(rmsnorm(x, ffn_norm[layer]), w_gate_up[layer], w_down[layer])
    return rmsnorm(x, final_norm)
```

```cpp
#include <hip/hip_runtime.h>
#include <stdint.h>
#include <stdio.h>
namespace pg8 {
#define PG8_LAS __attribute__((address_space(3)))
typedef unsigned short bf16_t;
typedef short bf16x8 __attribute__((ext_vector_type(8)));
typedef float f32x4 __attribute__((ext_vector_type(4)));
typedef unsigned u32x4 __attribute__((ext_vector_type(4)));
constexpr int BM = 256, BK = 64, HALF = 128, HTB = HALF * BK * 2  , STAGE_BYTES = 8 * HTB, NXCD = 8, WGM = 8;

__host__ __device__ __forceinline__ int lds_byte(int r, int c) { const int st = (r >> 4) * 2 + (c >> 5), rr = r & 15, cc = c & 31, ob = rr * 64 + cc * 2; return st * 1024 + (ob ^ (((ob >> 9) & 1) << 5)); }
__host__ __device__ __forceinline__ void stage_rc(int b, int& R, int& C) { const int st = b / 1024, sb = b % 1024, swz = sb ^ (((sb >> 9) & 1) << 5); R = (st >> 1) * 16 + swz / 64; C = (st & 1) * 32 + (swz % 64) / 2; }
__host__ __device__ __forceinline__ int perm32(int rho) { const int n = rho >> 4, i = rho & 15; return 8 * (i >> 2) + 4 * n + (i & 3); }

struct Unit { int pm, pn; };
struct Gemm { const bf16_t* A; const bf16_t* Bt; int M, N, K, pad_; };

struct StaticOrder {
    int nM, nN, nwg, G, c;
    __host__ __device__ void init(int M, int N, int G_, int c_) { nM = M / BM; nN = N / BM; nwg = nM * nN; G = G_; c = c_; }
    __host__ __device__ bool next(int i, Unit& u) const {
        const long L = (long)i * G + c; if (L >= nwg) return false;
        int wgid = (int)L; { const int q = nwg / NXCD, r = nwg % NXCD, xcd = wgid % NXCD, off = wgid / NXCD; wgid = (xcd < r ? xcd * (q + 1) : r * (q + 1) + (xcd - r) * q) + off; }
        const int nig = WGM * nN, gid = wgid / nig, fm = gid * WGM, gsz = (nM - fm) < WGM ? (nM - fm) : WGM;
        u.pm = fm + ((wgid % nig) % gsz); u.pn = (wgid % nig) / gsz; return true;
    }
    __device__ __forceinline__ void a_ready(const Unit&) const {}
    __device__ __forceinline__ void done(const Unit&) const {}
};
__device__ __forceinline__ unsigned cvt_pk_bf16(float lo, float hi) { unsigned r; asm volatile("v_cvt_pk_bf16_f32 %0, %1, %2" : "=v"(r) : "v"(lo), "v"(hi)); return r; }
typedef float f32x2 __attribute__((ext_vector_type(2)));
template <class Epi, class Sched, bool STAMP = false>
__device__ __forceinline__ void gemm_phase(PG8_LAS unsigned char* lds, const Gemm g, const Sched& S, const Epi& E, unsigned long long* stamps) {
    const int tid = threadIdx.x, wid = __builtin_amdgcn_readfirstlane(tid >> 6), lane = tid & 63, wr = wid >> 2, wc = wid & 3, fr = lane & 15, fq = lane >> 4;
    const int K = g.K, nt = K / BK;
    int ts_lo = 0, ts_hi = 0, nts = 0; const unsigned long long rt_entry = STAMP ? (unsigned long long)wall_clock64() : 0ull;
#define PG8_STAMP() do { if (STAMP && wid == 0 && nts < 64) { const unsigned long long _c = (unsigned long long)clock64(); \
        ts_lo = (lane == nts) ? (int)(unsigned)_c : ts_lo; ts_hi = (lane == nts) ? (int)(unsigned)(_c >> 32) : ts_hi; ++nts; } } while (0)
    PG8_STAMP();
    unsigned voffA[2], voffB[2];
#pragma unroll
    for (int i = 0; i < 2; ++i) { int R, C; stage_rc(tid * 16 + i * 8192, R, C); const int Rb = Epi::PERM ? ((R & ~31) + perm32(R & 31)) : R;
        voffA[i] = (unsigned)(R * K + C) * 2u; voffB[i] = (unsigned)(Rb * K + C) * 2u; }
    const size_t kstep = (size_t)(BK * 2);
    const size_t hstep = (size_t)HALF * K * 2;
    const size_t tstep = 2 * hstep;
    const unsigned ldsw = (unsigned)wid * 1024u;
    const int aoff = lds_byte(wr * 64 + fr, fq * 8), boff = lds_byte(wc * 32 + fr, fq * 8);
#define PG8_SA(b, h) (((b) * 2 + (h)) * HTB)
#define PG8_SB(b, h) ((4 + (b) * 2 + (h)) * HTB)
#define PG8_STAGE(bufoff, gbase, voff) do { _Pragma("unroll") for (int _i = 0; _i < 2; ++_i) \
        __builtin_amdgcn_global_load_lds((const unsigned*)((const char*)(gbase) + (voff)[_i]), (PG8_LAS unsigned*)(lds + (bufoff) + ldsw + _i * 8192), 16, 0, 0); } while (0)
#define PG8_LDA(dst, b, h) do { _Pragma("unroll") for (int m = 0; m < 4; ++m) _Pragma("unroll") for (int k = 0; k < 2; ++k) dst[m][k] = *(const PG8_LAS bf16x8*)(lds + PG8_SA(b, h) + aoff + m * 2048 + k * 1024); } while (0)
#define PG8_LDB(dst, b, h) do { _Pragma("unroll") for (int n = 0; n < 2; ++n) _Pragma("unroll") for (int k = 0; k < 2; ++k) dst[n][k] = *(const PG8_LAS bf16x8*)(lds + PG8_SB(b, h) + boff + n * 2048 + k * 1024); } while (0)
#define PG8_MMA(ai, bj, At, Bt) do { __builtin_amdgcn_s_setprio(1); _Pragma("unroll") for (int m = 0; m < 4; ++m) _Pragma("unroll") for (int n = 0; n < 2; ++n) _Pragma("unroll") for (int k = 0; k < 2; ++k) \
        acc[ai][bj][m][n] = __builtin_amdgcn_mfma_f32_16x16x32_bf16(Bt[n][k], At[m][k], acc[ai][bj][m][n], 0, 0, 0); __builtin_amdgcn_s_setprio(0); } while (0)
#define PG8_WAIT_V(n) asm volatile("s_waitcnt vmcnt(" #n ")" ::: "memory")
#define PG8_WAIT_L(n) asm volatile("s_waitcnt lgkmcnt(" #n ")" ::: "memory")
#define PG8_BAR __builtin_amdgcn_s_barrier()
#define PG8_SCHED __builtin_amdgcn_sched_barrier(0)
    Unit cur, nxt; int ui = 0;
    if (!S.next(0, cur)) return;
    f32x4 acc[2][2][4][2];
#pragma unroll
    for (int a = 0; a < 2; ++a)
#pragma unroll
        for (int b = 0; b < 2; ++b)
#pragma unroll
            for (int m = 0; m < 4; ++m)
#pragma unroll
                for (int n = 0; n < 2; ++n) acc[a][b][m][n] = (f32x4){0.f, 0.f, 0.f, 0.f};
    bf16x8 At[4][2], B0[2][2], B1[2][2];
    const char* cA = (const char*)g.A + (size_t)cur.pm * tstep; const char* cB = (const char*)g.Bt + (size_t)cur.pn * tstep;
    S.a_ready(cur);
    PG8_STAGE(PG8_SB(0, 0), cB, voffB); PG8_STAGE(PG8_SA(0, 0), cA, voffA); PG8_STAGE(PG8_SB(0, 1), cB + hstep, voffB); PG8_STAGE(PG8_SA(0, 1), cA + hstep, voffA);
    if (wr == 1) PG8_BAR;
    PG8_WAIT_V(4); PG8_BAR;
    PG8_STAGE(PG8_SB(1, 0), cB + kstep, voffB); PG8_STAGE(PG8_SA(1, 0), cA + kstep, voffA); PG8_STAGE(PG8_SB(1, 1), cB + hstep + kstep, voffB);
    PG8_WAIT_V(6); PG8_BAR;
    PG8_STAMP();
    for (;;) {
        const bool has_next = S.next(ui + 1, nxt);
        const char* nA = has_next ? (const char*)g.A + (size_t)nxt.pm * tstep : cA; const char* nB = has_next ? (const char*)g.Bt + (size_t)nxt.pn * tstep : cB;
        for (int t = 0; t < nt; t += 2) {
            const bool last = (t == nt - 2);
            const char* a1 = cA + (size_t)(t + 1) * kstep;
            const char* a2 = last ? nA : cA + (size_t)(t + 2) * kstep; const char* b2 = last ? nB : cB + (size_t)(t + 2) * kstep;
            const char* a3 = a2 + kstep; const char* b3 = b2 + kstep;
            if (last && has_next) S.a_ready(nxt);
            PG8_LDB(B0, 0, 0); PG8_SCHED; PG8_LDA(At, 0, 0); PG8_STAGE(PG8_SA(1, 1), a1 + hstep, voffA);
            PG8_WAIT_L(8); PG8_BAR; PG8_WAIT_L(0); PG8_MMA(0, 0, At, B0); PG8_BAR; PG8_SCHED;
            PG8_LDB(B1, 0, 1); PG8_STAGE(PG8_SB(0, 0), b2, voffB);
            PG8_BAR; PG8_WAIT_L(0); PG8_MMA(0, 1, At, B1); PG8_BAR;
            PG8_LDA(At, 0, 1); PG8_STAGE(PG8_SA(0, 0), a2, voffA);
            PG8_BAR; PG8_WAIT_L(0); PG8_MMA(1, 0, At, B0); PG8_BAR; PG8_SCHED;
            PG8_STAGE(PG8_SB(0, 1), b2 + hstep, voffB);
            PG8_WAIT_V(6); PG8_BAR; PG8_MMA(1, 1, At, B1); PG8_BAR;
            PG8_LDB(B0, 1, 0); PG8_SCHED; PG8_LDA(At, 1, 0); PG8_STAGE(PG8_SA(0, 1), a2 + hstep, voffA);
            PG8_WAIT_L(8); PG8_BAR; PG8_WAIT_L(0); PG8_MMA(0, 0, At, B0); PG8_BAR; PG8_SCHED;
            PG8_LDB(B1, 1, 1); PG8_STAGE(PG8_SB(1, 0), b3, voffB);
            PG8_BAR; PG8_WAIT_L(0); PG8_MMA(0, 1, At, B1); PG8_BAR;
            PG8_LDA(At, 1, 1); PG8_STAGE(PG8_SA(1, 0), a3, voffA);
            PG8_BAR; PG8_WAIT_L(0); PG8_MMA(1, 0, At, B0); PG8_BAR; PG8_SCHED;
            PG8_STAGE(PG8_SB(1, 1), b3 + hstep, voffB);
            PG8_WAIT_V(6); PG8_BAR; PG8_MMA(1, 1, At, B1); PG8_BAR;
        }
        PG8_STAMP();
        if constexpr (!Epi::AFTER_DRAIN) { E(acc, cur, wr, wc, fr, fq); S.done(cur); }
        PG8_STAMP();
        if (!has_next) break;
#pragma unroll
        for (int a = 0; a < 2; ++a)
#pragma unroll
            for (int b = 0; b < 2; ++b)
#pragma unroll
                for (int m = 0; m < 4; ++m)
#pragma unroll
                    for (int n = 0; n < 2; ++n) acc[a][b][m][n] = (f32x4){0.f, 0.f, 0.f, 0.f};
        cur = nxt; cA = nA; cB = nB; ++ui;
    }
    PG8_WAIT_V(0);
    if (wr == 0) PG8_BAR;
    PG8_BAR;
    if constexpr (Epi::AFTER_DRAIN) { E.fused(acc, cur, wr, wc, fr, fq, lds, wid, lane); S.done(cur); }
    PG8_STAMP();
    if (STAMP && wid == 0) { stamps[lane] = lane < nts ? (((unsigned long long)(unsigned)ts_hi << 32) | (unsigned)ts_lo) : 0ull;
        if (lane == 62) stamps[62] = rt_entry; if (lane == 63) stamps[63] = (unsigned long long)wall_clock64(); }
#undef PG8_STAMP
#undef PG8_SA
#undef PG8_SB
#undef PG8_STAGE
#undef PG8_LDA
#undef PG8_LDB
#undef PG8_MMA
#undef PG8_WAIT_V
#undef PG8_WAIT_L
#undef PG8_BAR
#undef PG8_SCHED
}
}
using pg8::bf16_t; using pg8::bf16x8; using pg8::f32x4; using pg8::u32x4;
#define LDSP __attribute__((address_space(3)))
typedef float f32x16 __attribute__((ext_vector_type(16)));
typedef float f32x2v __attribute__((ext_vector_type(2)));
typedef __bf16 bf16v2 __attribute__((ext_vector_type(2)));
typedef unsigned u32x2 __attribute__((ext_vector_type(2)));

constexpr int S = 16384, DM = 4096, DFF = 11008;
constexpr int ABW = 6912, NSW = 5728, NSWP = 5888;
constexpr float EPS = 1e-5f, SCALE = 0.08838834764831845f, LOG2E = 1.4426950408889634f, C2 = SCALE * LOG2E;
constexpr int NCMP = 1023, NCMPP = 1024;

constexpr size_t AL(size_t x) { return (x + 4095) & ~(size_t)4095; }
constexpr size_t OFF_BAR    = 0;
constexpr size_t OFF_DBG    = 16384;
constexpr size_t OFF_WT_ABIN  = 65536;
constexpr size_t OFF_WT_ABOUT = OFF_WT_ABIN  + AL((size_t)ABW * DM * 2);
constexpr size_t OFF_WT_GU0   = OFF_WT_ABOUT + AL((size_t)DM * DM * 2);
constexpr size_t OFF_WT_GU1   = OFF_WT_GU0   + AL((size_t)2 * DFF * DM * 2);
constexpr size_t OFF_WT_DN0   = OFF_WT_GU1   + AL((size_t)2 * DFF * DM * 2);
constexpr size_t OFF_WT_DN1   = OFF_WT_DN0   + AL((size_t)DM * DFF * 2);
constexpr size_t OFF_WT_NSIN  = OFF_WT_DN1   + AL((size_t)DM * DFF * 2);
constexpr size_t OFF_WT_NSOUT = OFF_WT_NSIN  + AL((size_t)NSWP * DM * 2);
constexpr size_t OFF_HB     = OFF_WT_NSOUT + AL((size_t)DM * DM * 2);
constexpr size_t OFF_OB     = OFF_HB   + AL((size_t)S * DM * 2);
constexpr size_t OFF_QKV    = OFF_OB   + AL((size_t)S * DM * 2);
constexpr size_t OFF_HID    = OFF_QKV  + AL((size_t)S * ABW * 2);
constexpr size_t OFF_X1     = OFF_HID  + AL((size_t)S * DFF * 2);
constexpr size_t OFF_X2     = OFF_X1   + AL((size_t)S * DM * 4);
constexpr size_t OFF_OACC   = OFF_X2   + AL((size_t)S * DM * 4);
constexpr size_t OFF_VTA    = OFF_OACC + AL((size_t)S * DM * 4);
constexpr size_t OFF_VTB    = OFF_VTA  + AL((size_t)1024 * S * 2);
constexpr size_t OFF_VTS    = OFF_VTB  + AL((size_t)384 * S * 2);
constexpr size_t OFF_VTW    = OFF_VTS  + AL((size_t)256 * S * 2);
constexpr size_t OFF_KCMP   = OFF_VTW  + AL((size_t)256 * S * 2);
constexpr size_t OFF_VCMPT  = OFF_KCMP + AL((size_t)2 * NCMPP * 128 * 2);
constexpr size_t OFF_IDX    = OFF_VCMPT + AL((size_t)2 * NCMPP * 128 * 2);
constexpr size_t OFF_SCR    = OFF_IDX  + AL((size_t)S * 2 * 8 * 4);
constexpr size_t WS_NEED    = OFF_SCR  + AL((size_t)64 << 20);

__device__ __forceinline__ unsigned pk2(float a, float b) { f32x2v v = {a, b}; return __builtin_bit_cast(unsigned, __builtin_convertvector(v, bf16v2)); }
__device__ __forceinline__ float bf2f(bf16_t x) { return __uint_as_float(((unsigned)x) << 16); }
__device__ __forceinline__ float ex2(float x) { return __builtin_amdgcn_exp2f(x); }
__device__ __forceinline__ float lg2(float x) { return __builtin_amdgcn_logf(x); }
__device__ __forceinline__ float sigmoidf_(float x) { return __builtin_amdgcn_rcpf(1.f + ex2(-x * LOG2E)); }
#define MFMA32(a, b, c) __builtin_amdgcn_mfma_f32_32x32x16_bf16((a), (b), (c), 0, 0, 0)
#define MFMA16(a, b, c) __builtin_amdgcn_mfma_f32_16x16x32_bf16((a), (b), (c), 0, 0, 0)
struct EpiBf16 {
    static constexpr bool PERM = true, AFTER_DRAIN = false;
    bf16_t* O; int ldc, pad_;
    __device__ __forceinline__ void operator()(const f32x4 (&acc)[2][2][4][2], const pg8::Unit& u, int wr, int wc, int fr, int fq) const {
        const int row0 = u.pm * 256 + wr * 64 + fr, col0 = u.pn * 256 + wc * 32 + 8 * fq;
#pragma unroll
        for (int ai = 0; ai < 2; ++ai)
#pragma unroll
            for (int m = 0; m < 4; ++m) { bf16_t* rowp = O + (size_t)(row0 + ai * 128 + m * 16) * ldc + col0;
#pragma unroll
                for (int bj = 0; bj < 2; ++bj) { const f32x4 v0 = acc[ai][bj][m][0], v1 = acc[ai][bj][m][1];
                    u32x4 w; w.x = pk2(v0[0], v0[1]); w.y = pk2(v0[2], v0[3]); w.z = pk2(v1[0], v1[1]); w.w = pk2(v1[2], v1[3]);
                    *(u32x4*)(rowp + bj * 128) = w; } }
    }
};
struct EpiRes {
    static constexpr bool PERM = false, AFTER_DRAIN = false;
    const float* base; float* out; int ldc, pad_;
    __device__ __forceinline__ void operator()(const f32x4 (&acc)[2][2][4][2], const pg8::Unit& u, int wr, int wc, int fr, int fq) const {
        const int row0 = u.pm * 256 + wr * 64 + fr, col0 = u.pn * 256 + wc * 32 + 4 * fq;
#pragma unroll
        for (int ai = 0; ai < 2; ++ai)
#pragma unroll
            for (int m = 0; m < 4; ++m) { const size_t off = (size_t)(row0 + ai * 128 + m * 16) * ldc + col0;
#pragma unroll
                for (int bj = 0; bj < 2; ++bj)
#pragma unroll
                    for (int n = 0; n < 2; ++n) { const f32x4 b = *(const f32x4*)(base + off + bj * 128 + n * 16);
                        *(f32x4*)(out + off + bj * 128 + n * 16) = b + acc[ai][bj][m][n]; } }
    }
};
struct EpiSwiGLU {
    static constexpr bool PERM = true, AFTER_DRAIN = false;
    bf16_t* H; int ldh, pad_;
    __device__ __forceinline__ void operator()(const f32x4 (&acc)[2][2][4][2], const pg8::Unit& u, int wr, int wc, int fr, int fq) const {
        const int row0 = u.pm * 256 + wr * 64 + fr, col0 = u.pn * 128 + wc * 32 + 8 * fq;
#pragma unroll
        for (int ai = 0; ai < 2; ++ai)
#pragma unroll
            for (int m = 0; m < 4; ++m) { bf16_t* rowp = H + (size_t)(row0 + ai * 128 + m * 16) * ldh + col0;
                float hv[8];
#pragma unroll
                for (int n = 0; n < 2; ++n)
#pragma unroll
                    for (int e = 0; e < 4; ++e) { const float gt = acc[ai][0][m][n][e], up = acc[ai][1][m][n][e]; hv[n * 4 + e] = gt * sigmoidf_(gt) * up; }
                u32x4 w; w.x = pk2(hv[0], hv[1]); w.y = pk2(hv[2], hv[3]); w.z = pk2(hv[4], hv[5]); w.w = pk2(hv[6], hv[7]);
                *(u32x4*)rowp = w; }
    }
};

struct CvtJob { const float* src; bf16_t* dst; int K, N, Nout, mode, tile0, ntn; };
constexpr int NCVT = 8;
struct CvtJobs { CvtJob j[NCVT]; int total; int pad_; };
__device__ __forceinline__ void cvt_tile(const CvtJob& J, int tn, int tk, LDSP float* t  ) {
    const int tid = threadIdx.x;
    const int rho0 = tn * 64;
    int col0;
    if (J.mode == 1) { const int pn = rho0 >> 8, bj = (rho0 >> 7) & 1, cc = rho0 & 127; col0 = bj * DFF + pn * 128 + cc; } else col0 = rho0;
#pragma unroll
    for (int i = 0; i < 2; ++i) { const int idx = tid + 512 * i, kr = idx >> 4, c4 = (idx & 15) * 4;
        f32x4 v = {0.f, 0.f, 0.f, 0.f};
        if (col0 + c4 < J.N) v = *(const f32x4*)(J.src + (size_t)(tk * 64 + kr) * J.N + col0 + c4);
        t[kr * 65 + c4 + 0] = v[0]; t[kr * 65 + c4 + 1] = v[1]; t[kr * 65 + c4 + 2] = v[2]; t[kr * 65 + c4 + 3] = v[3]; }
    __syncthreads();
    { const int nn = tid >> 3, k8 = (tid & 7) * 8; float f[8];
#pragma unroll
      for (int e = 0; e < 8; ++e) f[e] = t[(k8 + e) * 65 + nn];
      u32x4 w; w.x = pk2(f[0], f[1]); w.y = pk2(f[2], f[3]); w.z = pk2(f[4], f[5]); w.w = pk2(f[6], f[7]);
      *(u32x4*)(J.dst + (size_t)(rho0 + nn) * J.K + tk * 64 + k8) = w; }
    __syncthreads();
}
__device__ __forceinline__ void cvt_phase(const CvtJobs& js, LDSP char* lds, int bid, int nb) {
    LDSP float* t = (LDSP float*)lds;
    for (int T = bid; T < js.total; T += nb) {
        int ji = 0;
#pragma unroll
        for (int q = 1; q < NCVT; ++q) if (T >= js.j[q].tile0) ji = q;
        const CvtJob& J = js.j[ji]; const int lt = T - J.tile0;
        cvt_tile(J, lt % J.ntn, lt / J.ntn, t);
    }
}

template <bool F32OUT>
__device__ __forceinline__ void rmsnorm_phase(const float* x, const float* g, bf16_t* hb, float* hf, int bid, int nb) {
    const int wid = threadIdx.x >> 6, lane = threadIdx.x & 63;
    for (int row = bid * 8 + wid; row < S; row += nb * 8) {
        const float* xr = x + (size_t)row * DM;
        f32x4 v[16]; float ss = 0.f;
#pragma unroll
        for (int j = 0; j < 16; ++j) { v[j] = *(const f32x4*)(xr + (j * 64 + lane) * 4); ss += v[j][0] * v[j][0] + v[j][1] * v[j][1] + v[j][2] * v[j][2] + v[j][3] * v[j][3]; }
#pragma unroll
        for (int o = 32; o >= 1; o >>= 1) ss += __shfl_xor(ss, o);
        const float rstd = 1.0f / sqrtf(ss * (1.0f / DM) + EPS);
#pragma unroll
        for (int j = 0; j < 16; ++j) { const int c = (j * 64 + lane) * 4; const f32x4 gg = *(const f32x4*)(g + c);
            const f32x4 y = v[j] * rstd * gg;
            if (F32OUT) *(f32x4*)(hf + (size_t)row * DM + c) = y;
            else { u32x2 w; w.x = pk2(y[0], y[1]); w.y = pk2(y[2], y[3]); *(u32x2*)(hb + (size_t)row * DM + c) = w; } }
    }
}

__device__ __forceinline__ void vtrans_phase(const bf16_t* src, int ld, int c0, int ncols, bf16_t* dst, LDSP char* lds, int bid, int nb) {
    LDSP bf16_t* t = (LDSP bf16_t*)lds;
    const int tid = threadIdx.x, nct = ncols / 64, total = (S / 64) * nct;
    for (int T = bid; T < total; T += nb) {
        const int tt = T / nct, ct = T % nct;
        { const int tr = tid >> 3, c8 = (tid & 7) * 8;
          const u32x4 v = *(const u32x4*)(src + (size_t)(tt * 64 + tr) * ld + c0 + ct * 64 + c8);
          *(LDSP u32x4*)(t + tr * 72 + c8) = v; }
        __syncthreads();
        { const int col = tid >> 3, t8 = (tid & 7) * 8; unsigned short e[8];
#pragma unroll
          for (int q = 0; q < 8; ++q) e[q] = t[(t8 + q) * 72 + col];
          u32x4 w; w.x = e[0] | ((unsigned)e[1] << 16); w.y = e[2] | ((unsigned)e[3] << 16); w.z = e[4] | ((unsigned)e[5] << 16); w.w = e[6] | ((unsigned)e[7] << 16);
          *(u32x4*)(dst + (size_t)(ct * 64 + col) * S + tt * 64 + t8) = w; }
        __syncthreads();
    }
}
constexpr int KROW = 272, VROW = 144, KT_BYTES = 64 * KROW, VT_BYTES = 128 * VROW;
__device__ __forceinline__ int kperm_row(int kap) { const int i = kap & 15; return (kap & 32) + (i & 3) + 8 * (i >> 2) + 4 * ((kap >> 4) & 1); }
__device__ __forceinline__ void ld_k_tile(LDSP char* kl, const bf16_t* Kg, size_t ldk, int kbase) {
    const int tid = threadIdx.x;
#pragma unroll
    for (int i = 0; i < 2; ++i) { const int c = tid + 512 * i, row = c >> 4, c16 = c & 15;
        const u32x4 v = *(const u32x4*)(Kg + (size_t)(kbase + row) * ldk + c16 * 8);
        *(LDSP u32x4*)(kl + kperm_row(row) * KROW + c16 * 16) = v; }
}
__device__ __forceinline__ void ld_vt_tile(LDSP char* vl, const bf16_t* VTg, size_t ldv, int kbase) {
    const int tid = threadIdx.x;
#pragma unroll
    for (int i = 0; i < 2; ++i) { const int c = tid + 512 * i, row = c >> 3, c16 = c & 7;
        const u32x4 v = *(const u32x4*)(VTg + (size_t)row * ldv + kbase + c16 * 8);
        *(LDSP u32x4*)(vl + row * VROW + c16 * 16) = v; }
}
__device__ __forceinline__ void qk_tile(f32x16& p0, f32x16& p1, const LDSP char* kl, const bf16x8 (&qr)[8], int r, int h) {
#pragma unroll
    for (int i = 0; i < 16; ++i) { p0[i] = 0.f; p1[i] = 0.f; }
    const LDSP char* a = kl + r * KROW + h * 16;
#pragma unroll
    for (int d0 = 0; d0 < 8; ++d0) {
        const bf16x8 a0 = *(const LDSP bf16x8*)(a + d0 * 32);
        const bf16x8 a1 = *(const LDSP bf16x8*)(a + 32 * KROW + d0 * 32);
        p0 = MFMA32(a0, qr[d0], p0); p1 = MFMA32(a1, qr[d0], p1); }
}
__device__ __forceinline__ bf16x8 pack8(const f32x16& p, int s8) {
    u32x4 w; w.x = pk2(p[s8 + 0], p[s8 + 1]); w.y = pk2(p[s8 + 2], p[s8 + 3]); w.z = pk2(p[s8 + 4], p[s8 + 5]); w.w = pk2(p[s8 + 6], p[s8 + 7]);
    return __builtin_bit_cast(bf16x8, w);
}
__device__ __forceinline__ void pv_tile(f32x16 (&o)[4], const f32x16& p0, const f32x16& p1, const LDSP char* vl, int r, int h) {
#pragma unroll
    for (int kb = 0; kb < 2; ++kb)
#pragma unroll
        for (int s = 0; s < 2; ++s) {
            const bf16x8 pb = kb ? pack8(p1, 8 * s) : pack8(p0, 8 * s);
#pragma unroll
            for (int d0 = 0; d0 < 4; ++d0) {
                const bf16x8 a = *(const LDSP bf16x8*)(vl + (32 * d0 + r) * VROW + (32 * kb + 16 * h + 8 * s) * 2);
                o[d0] = MFMA32(a, pb, o[d0]); } }
}
__device__ __forceinline__ void load_q(bf16x8 (&qr)[8], const bf16_t* qp  ) {
#pragma unroll
    for (int d0 = 0; d0 < 8; ++d0) qr[d0] = *(const bf16x8*)(qp + 16 * d0);
}

__device__ __forceinline__ float sb_block(f32x16& p, int kpos0, int t, float carry, int h) {
    float z[16], suf[16]; float run = 0.f;
#pragma unroll
    for (int i = 15; i >= 0; --i) { z[i] = p[i] * C2; const bool valid = (kpos0 + i) < t;
        const float sp = fmaxf(z[i], 0.f) + lg2(1.f + ex2(-fabsf(z[i])));
        run += valid ? -sp : 0.f; suf[i] = run; }
    const float T = run, PT = __shfl_xor(T, 32);
    const float add = carry + (h == 0 ? PT : 0.f);
#pragma unroll
    for (int i = 0; i < 16; ++i) { const bool valid = (kpos0 + i) < t; p[i] = valid ? ex2(z[i] + suf[i] + add) : 0.f; }
    return T + PT;
}
__device__ __forceinline__ void sb_unit(const bf16_t* qkv, const bf16_t* vta, bf16_t* ob, int head, int qb, LDSP char* lds) {
    const int tid = threadIdx.x, wid = __builtin_amdgcn_readfirstlane(tid >> 6), lane = tid & 63, r = lane & 31, h = lane >> 5;
    const int t0 = qb * 256, tq0 = t0 + 32 * wid, t = tq0 + r;
    LDSP char* kl = lds; LDSP char* vl = lds + KT_BYTES;
    bf16x8 qr[8]; load_q(qr, qkv + (size_t)t * ABW + head * 128 + 8 * h);
    const bf16_t* Kg = qkv + 1024 + head * 128;
    const bf16_t* Vg = vta + (size_t)head * 128 * S;
    f32x16 o[4];
#pragma unroll
    for (int d0 = 0; d0 < 4; ++d0)
#pragma unroll
        for (int i = 0; i < 16; ++i) o[d0][i] = 0.f;
    float carry = 0.f;
    const int jhi = (t0 + 254) >> 6;
    for (int j = jhi; j >= 0; --j) {
        __syncthreads();
        ld_k_tile(kl, Kg, ABW, j * 64); ld_vt_tile(vl, Vg, S, j * 64);
        __syncthreads();
        if (j * 64 < tq0 + 31) {
            f32x16 p0, p1; qk_tile(p0, p1, kl, qr, r, h);
            const float b1 = sb_block(p1, j * 64 + 32 + 16 * h, t, carry, h);
            const float b0 = sb_block(p0, j * 64 + 16 * h, t, carry + b1, h);
            carry += b1 + b0;
            pv_tile(o, p0, p1, vl, r, h);
        }
    }
    bf16_t* op = ob + (size_t)t * DM + head * 128 + 4 * h;
#pragma unroll
    for (int d0 = 0; d0 < 4; ++d0)
#pragma unroll
        for (int g = 0; g < 4; ++g) { u32x2 w; w.x = pk2(o[d0][4 * g], o[d0][4 * g + 1]); w.y = pk2(o[d0][4 * g + 2], o[d0][4 * g + 3]); *(u32x2*)(op + 32 * d0 + 8 * g) = w; }
}

template <int W, bool SINK, bool NSAWIN>
__device__ __forceinline__ void win_unit(const bf16_t* qkv, int ld, int qcol, int kcol, const bf16_t* vt, float slope, float sinkv, float gate,
                                         const float* oacc, bf16_t* ob, int ocol, int qt, LDSP char* lds) {
    const int tid = threadIdx.x, lane = tid & 63, r = lane & 31, h = lane >> 5;
    const int t0 = qt * 32, t = t0 + r;
    LDSP char* kl = lds; LDSP char* vl = lds + KT_BYTES;
    bf16x8 qr[8]; load_q(qr, qkv + (size_t)t * ld + qcol + 8 * h);
    const float slope2 = slope * LOG2E;
    float m = SINK ? sinkv * LOG2E : -1e30f, l = SINK ? 1.f : 0.f;
    f32x16 o[4];
#pragma unroll
    for (int d0 = 0; d0 < 4; ++d0)
#pragma unroll
        for (int i = 0; i < 16; ++i) o[d0][i] = 0.f;
    int lowk = t0 - (W - 1); if (lowk < 0) lowk = 0;
    const int jlo = lowk >> 6, jhi = (t0 + 31) >> 6;
    const float NINF = -__builtin_inff();
    for (int j = jlo; j <= jhi; ++j) {
        __syncthreads();
        ld_k_tile(kl, qkv + kcol, ld, j * 64); ld_vt_tile(vl, vt, S, j * 64);
        __syncthreads();
        f32x16 p0, p1; qk_tile(p0, p1, kl, qr, r, h);
        float mx = NINF;
#pragma unroll
        for (int i = 0; i < 16; ++i) { const int d0_ = t - (j * 64 + 16 * h + i), d1_ = d0_ - 32;
            p0[i] = ((unsigned)d0_ < (unsigned)W) ? p0[i] * C2 - slope2 * (float)d0_ : NINF;
            p1[i] = ((unsigned)d1_ < (unsigned)W) ? p1[i] * C2 - slope2 * (float)d1_ : NINF;
            mx = fmaxf(mx, fmaxf(p0[i], p1[i])); }
        mx = fmaxf(mx, __shfl_xor(mx, 32));
        const float mn = fmaxf(m, mx), alpha = ex2(m - mn); m = mn;
        float ps = 0.f;
#pragma unroll
        for (int i = 0; i < 16; ++i) { p0[i] = ex2(p0[i] - mn); p1[i] = ex2(p1[i] - mn); ps += p0[i] + p1[i]; }
        ps += __shfl_xor(ps, 32);
        l = l * alpha + ps;
#pragma unroll
        for (int d0 = 0; d0 < 4; ++d0)
#pragma unroll
            for (int i = 0; i < 16; ++i) o[d0][i] *= alpha;
        pv_tile(o, p0, p1, vl, r, h);
    }
    const float inv = (NSAWIN ? gate : 1.f) / l;
    bf16_t* op = ob + (size_t)t * DM + ocol + 4 * h;
    const float* ap = oacc + (size_t)t * DM + ocol + 4 * h;
#pragma unroll
    for (int d0 = 0; d0 < 4; ++d0)
#pragma unroll
        for (int g = 0; g < 4; ++g) {
            f32x4 v = {o[d0][4 * g] * inv, o[d0][4 * g + 1] * inv, o[d0][4 * g + 2] * inv, o[d0][4 * g + 3] * inv};
            if (NSAWIN) v += *(const f32x4*)(ap + 32 * d0 + 8 * g);
            u32x2 w; w.x = pk2(v[0], v[1]); w.y = pk2(v[2], v[3]); *(u32x2*)(op + 32 * d0 + 8 * g) = w; }
}
__device__ __forceinline__ float slope_l0(int kvh, int g) { return exp2f(-8.f * (float)(3 * g + kvh + 1) / 24.f); }
__device__ __forceinline__ float slope_l1(int kvh, int g) { return exp2f(-8.f * (float)(2 * g + kvh + 1) / 32.f); }

#define LADD(p, v) ((void)__hip_atomic_fetch_add((p), (v), __ATOMIC_RELAXED, __HIP_MEMORY_SCOPE_WORKGROUP))
__device__ __forceinline__ void cmp_scores(f32x16& p0, f32x16& p1, int t, int cbase, int h, float slope2, float& mx) {
    const float NINF = -__builtin_inff();
#pragma unroll
    for (int i = 0; i < 16; ++i) { const int d0_ = t - 16 * (cbase + 16 * h + i) - 31, d1_ = d0_ - 512;
        p0[i] = d0_ >= 0 ? p0[i] * C2 - slope2 * (float)d0_ : NINF;
        p1[i] = d1_ >= 0 ? p1[i] * C2 - slope2 * (float)d1_ : NINF;
        mx = fmaxf(mx, fmaxf(p0[i], p1[i])); }
}
__device__ __forceinline__ void cmp_unit(const bf16_t* qkv, const bf16_t* kcmp, const bf16_t* vcmpt, float* oacc, int* idx, int kvh, int qt, LDSP char* lds) {
    const int tid = threadIdx.x, wid = __builtin_amdgcn_readfirstlane(tid >> 6), lane = tid & 63, r = lane & 31, h = lane >> 5;
    const int t0 = qt * 32, t = t0 + r;
    LDSP char* kl = lds; LDSP char* vl = lds + KT_BYTES;
    LDSP unsigned* imp = (LDSP unsigned*)(lds + KT_BYTES + VT_BYTES);
    for (int i = tid; i < 32 * 257; i += 512) imp[i] = 0u;
    const int ntiles = ((t0 >> 4) >> 6) + 1;
    const bf16_t* Kg = kcmp + (size_t)kvh * NCMPP * 128;
    const bf16_t* Vg = vcmpt + (size_t)kvh * 128 * NCMPP;
    for (int hh = 0; hh < 2; ++hh) {
        const int g = 2 * wid + hh, hq = kvh * 16 + g;
        const float slope2 = slope_l1(kvh, g) * LOG2E;
        bf16x8 qr[8]; load_q(qr, qkv + (size_t)t * NSWP + hq * 128 + 8 * h);
        float m = -1e30f, l = 0.f;
        for (int j = 0; j < ntiles; ++j) {
            __syncthreads();
            ld_k_tile(kl, Kg, 128, j * 64);
            __syncthreads();
            f32x16 p0, p1; qk_tile(p0, p1, kl, qr, r, h);
            float mx = -__builtin_inff(); cmp_scores(p0, p1, t, j * 64, h, slope2, mx);
            mx = fmaxf(mx, __shfl_xor(mx, 32));
            const float mn = fmaxf(m, mx); float ps = 0.f;
#pragma unroll
            for (int i = 0; i < 16; ++i) ps += ex2(p0[i] - mn) + ex2(p1[i] - mn);
            ps += __shfl_xor(ps, 32);
            l = l * ex2(m - mn) + ps; m = mn;
        }
        const float linv = 1.f / fmaxf(l, 1e-30f);
        f32x16 o[4];
#pragma unroll
        for (int d0 = 0; d0 < 4; ++d0)
#pragma unroll
            for (int i = 0; i < 16; ++i) o[d0][i] = 0.f;
        for (int j = 0; j < ntiles; ++j) {
            __syncthreads();
            ld_k_tile(kl, Kg, 128, j * 64); ld_vt_tile(vl, Vg, NCMPP, j * 64);
            __syncthreads();
            f32x16 p0, p1; qk_tile(p0, p1, kl, qr, r, h);
            float mx = 0.f; cmp_scores(p0, p1, t, j * 64, h, slope2, mx);
#pragma unroll
            for (int i = 0; i < 16; ++i) { p0[i] = ex2(p0[i] - m) * linv; p1[i] = ex2(p1[i] - m) * linv; }
            LDSP unsigned* ir = imp + r * 257 + 16 * j + 4 * h;
#pragma unroll
            for (int q4 = 0; q4 < 4; ++q4) {
                const float s0 = (p0[4 * q4] + p0[4 * q4 + 1]) + (p0[4 * q4 + 2] + p0[4 * q4 + 3]);
                const float s1 = (p1[4 * q4] + p1[4 * q4 + 1]) + (p1[4 * q4 + 2] + p1[4 * q4 + 3]);
                LADD(ir + q4, (unsigned)(s0 * 16777216.f + 0.5f));
                LADD(ir + q4 + 1, (unsigned)(p0[4 * q4 + 3] * 16777216.f + 0.5f));
                LADD(ir + 8 + q4, (unsigned)(s1 * 16777216.f + 0.5f));
                LADD(ir + 8 + q4 + 1, (unsigned)(p1[4 * q4 + 3] * 16777216.f + 0.5f)); }
            pv_tile(o, p0, p1, vl, r, h);
        }
        const float gate = sigmoidf_(bf2f(qkv[(size_t)t * NSWP + 5632 + kvh * 48 + g * 3 + 0]));
        float* op = oacc + (size_t)t * DM + hq * 128 + 4 * h;
#pragma unroll
        for (int d0 = 0; d0 < 4; ++d0)
#pragma unroll
            for (int gq = 0; gq < 4; ++gq) { const f32x4 v = {o[d0][4 * gq] * gate, o[d0][4 * gq + 1] * gate, o[d0][4 * gq + 2] * gate, o[d0][4 * gq + 3] * gate};
                *(f32x4*)(op + 32 * d0 + 8 * gq) = v; }
    }
    __syncthreads();
    for (int qq = 0; qq < 4; ++qq) {
        const int rq = wid * 4 + qq, tq = t0 + rq, cur = tq >> 6;
        unsigned long long key[4];
#pragma unroll
        for (int e = 0; e < 4; ++e) { const int j = lane + 64 * e; const bool valid = j <= cur, forced = (j == 0) || (j == cur) || (j == cur - 1);
            const unsigned sc = imp[rq * 257 + j] + (forced ? (1u << 30) : 0u);
            const unsigned long long lowb = (unsigned long long)(((255 - j) << 1) | 1);
            key[e] = valid ? ((((unsigned long long)sc + 1ull) << 9) | lowb) : lowb; }
        for (int rd = 0; rd < 8; ++rd) {
            unsigned long long best = key[0];
#pragma unroll
            for (int e = 1; e < 4; ++e) best = key[e] > best ? key[e] : best;
#pragma unroll
            for (int o_ = 32; o_ >= 1; o_ >>= 1) { const unsigned long long ot = __shfl_xor(best, o_); best = ot > best ? ot : best; }
            const int jsel = 255 - (int)((best >> 1) & 255ull);
            if (lane == 0) idx[((size_t)tq * 2 + kvh) * 8 + rd] = jsel;
#pragma unroll
            for (int e = 0; e < 4; ++e) if (lane + 64 * e == jsel) key[e] = 0ull;
        }
    }
    __syncthreads();
}
__device__ __forceinline__ void slc_item(const bf16_t* qkv, const bf16_t* vts, const int* idx, float* oacc, int t, int kvh) {
    const int lane = threadIdx.x & 63, g = lane & 15, quad = lane >> 4;
    const int hq = kvh * 16 + g;
    bf16x8 qf[4];
#pragma unroll
    for (int d0 = 0; d0 < 4; ++d0) qf[d0] = *(const bf16x8*)(qkv + (size_t)t * NSWP + hq * 128 + 32 * d0 + 8 * quad);
    const float slope2 = slope_l1(kvh, g) * LOG2E;
    float m = -1e30f, l = 0.f;
    f32x4 o[8];
#pragma unroll
    for (int dt = 0; dt < 8; ++dt) o[dt] = (f32x4){0.f, 0.f, 0.f, 0.f};
    const int* ip = idx + ((size_t)t * 2 + kvh) * 8;
    const float NINF = -__builtin_inff();
    for (int b = 0; b < 8; ++b) {
        const int blk = __builtin_amdgcn_readfirstlane(ip[b]);
        const int kbase = blk * 64;
        if (kbase > t) continue;
        f32x4 sc[4];
#pragma unroll
        for (int kt = 0; kt < 4; ++kt) { f32x4 acc = {0.f, 0.f, 0.f, 0.f};
            const bf16_t* kp = qkv + (size_t)(kbase + 16 * kt + g) * NSWP + 4608 + kvh * 128 + 8 * quad;
#pragma unroll
            for (int d0 = 0; d0 < 4; ++d0) acc = MFMA16(*(const bf16x8*)(kp + 32 * d0), qf[d0], acc);
            sc[kt] = acc; }
        float mx = NINF;
#pragma unroll
        for (int kt = 0; kt < 4; ++kt)
#pragma unroll
            for (int i = 0; i < 4; ++i) { const int dist = t - (kbase + 16 * kt + 4 * quad + i);
                sc[kt][i] = dist >= 0 ? sc[kt][i] * C2 - slope2 * (float)dist : NINF; mx = fmaxf(mx, sc[kt][i]); }
        mx = fmaxf(mx, __shfl_xor(mx, 16)); mx = fmaxf(mx, __shfl_xor(mx, 32));
        const float mn = fmaxf(m, mx), alpha = ex2(m - mn); m = mn;
        float ps = 0.f;
#pragma unroll
        for (int kt = 0; kt < 4; ++kt)
#pragma unroll
            for (int i = 0; i < 4; ++i) { sc[kt][i] = ex2(sc[kt][i] - mn); ps += sc[kt][i]; }
        ps += __shfl_xor(ps, 16); ps += __shfl_xor(ps, 32);
        l = l * alpha + ps;
#pragma unroll
        for (int dt = 0; dt < 8; ++dt) o[dt] *= alpha;
#pragma unroll
        for (int kk = 0; kk < 2; ++kk) {
            u32x4 pw; pw.x = pk2(sc[2 * kk][0], sc[2 * kk][1]); pw.y = pk2(sc[2 * kk][2], sc[2 * kk][3]); pw.z = pk2(sc[2 * kk + 1][0], sc[2 * kk + 1][1]); pw.w = pk2(sc[2 * kk + 1][2], sc[2 * kk + 1][3]);
            const bf16x8 pb = __builtin_bit_cast(bf16x8, pw);
#pragma unroll
            for (int dt = 0; dt < 8; ++dt) {
                const bf16_t* vp = vts + (size_t)(kvh * 128 + 16 * dt + g) * S + kbase + 32 * kk + 4 * quad;
                const u32x2 lo = *(const u32x2*)vp, hi = *(const u32x2*)(vp + 16);
                u32x4 aw; aw.x = lo.x; aw.y = lo.y; aw.z = hi.x; aw.w = hi.y;
                o[dt] = MFMA16(__builtin_bit_cast(bf16x8, aw), pb, o[dt]); } }
    }
    const float gate = sigmoidf_(bf2f(qkv[(size_t)t * NSWP + 5632 + kvh * 48 + g * 3 + 1]));
    const float sc_ = gate / l;
#pragma unroll
    for (int dt = 0; dt < 8; ++dt) { float* op = oacc + (size_t)t * DM + hq * 128 + 16 * dt + 4 * quad;
        f32x4 v = *(const f32x4*)op; v += o[dt] * sc_; *(f32x4*)op = v; }
}

__device__ __forceinline__ float gelu_tanh(float x) { const float u = 0.7978845608028654f * (x + 0.044715f * x * x * x); const float e = ex2(-2.f * LOG2E * fabsf(u)); const float th = (1.f - e) / (1.f + e); return 0.5f * x * (1.f + (u < 0.f ? -th : th)); }
__device__ __forceinline__ void cmp_mlp_unit(const bf16_t* qkv, const float* pos, const float* w1, const float* w2, bf16_t* kcmp, bf16_t* vcmpt, int which, int kvh, int grp, LDSP char* lds) {
    LDSP float* in = (LDSP float*)lds;
    LDSP float* part = in + 144 * 128;
    LDSP float* hid = part + 4 * 9 * 128;
    const int tid = threadIdx.x, n = tid & 127, sub = tid >> 7;
    const int i0 = grp * 8, tok0 = i0 * 16, scol = (which ? 4352 : 4096) + kvh * 128;
    for (int e = tid; e < 144 * 16; e += 512) { const int tk = e >> 4, c8 = (e & 15) * 8; const int tok = tok0 + tk;
        u32x4 v = {0u, 0u, 0u, 0u}; if (tok < S) v = *(const u32x4*)(qkv + (size_t)tok * NSWP + scol + c8);
        LDSP float* d = in + tk * 128 + c8;
        d[0] = __uint_as_float(v.x << 16); d[1] = __uint_as_float(v.x & 0xffff0000u); d[2] = __uint_as_float(v.y << 16); d[3] = __uint_as_float(v.y & 0xffff0000u);
        d[4] = __uint_as_float(v.z << 16); d[5] = __uint_as_float(v.z & 0xffff0000u); d[6] = __uint_as_float(v.w << 16); d[7] = __uint_as_float(v.w & 0xffff0000u); }
    __syncthreads();
    float acc[8], accb = 0.f;
#pragma unroll
    for (int c = 0; c < 8; ++c) acc[c] = 0.f;
    for (int lp = sub * 8; lp < sub * 8 + 8; ++lp)
        for (int d = 0; d < 128; ++d) { const float wv = w1[(size_t)(lp * 128 + d) * 128 + n]; accb += pos[lp * 128 + d] * wv;
#pragma unroll
            for (int c = 0; c < 8; ++c) acc[c] += in[(16 * c + lp) * 128 + d] * wv; }
#pragma unroll
    for (int c = 0; c < 8; ++c) part[(sub * 9 + c) * 128 + n] = acc[c];
    part[(sub * 9 + 8) * 128 + n] = accb;
    __syncthreads();
#pragma unroll
    for (int cc = 0; cc < 2; ++cc) { const int c = sub * 2 + cc; float s = 0.f;
#pragma unroll
        for (int q = 0; q < 4; ++q) s += part[(q * 9 + c) * 128 + n] + part[(q * 9 + 8) * 128 + n];
        hid[c * 128 + n] = gelu_tanh(s); }
    __syncthreads();
#pragma unroll
    for (int cc = 0; cc < 2; ++cc) { const int c = sub * 2 + cc; float s = 0.f;
        for (int k = 0; k < 128; ++k) s += hid[c * 128 + k] * w2[k * 128 + n];
        const int ci = i0 + c; if (ci >= NCMP) s = 0.f;
        const bf16_t bv = (bf16_t)(pk2(s, 0.f) & 0xffffu);
        if (which == 0) kcmp[((size_t)kvh * NCMPP + ci) * 128 + n] = bv; else vcmpt[((size_t)kvh * 128 + n) * NCMPP + ci] = bv; }
    __syncthreads();
}
struct Ptrs {
    const float *x, *attn_norm, *ffn_norm, *w_gate_up, *w_down, *ab_w_in, *ab_sinks, *ab_w_out, *nsa_w_in, *cmp_pos, *wk1, *wk2, *wv1, *wv2, *nsa_w_out, *final_norm;
    float* out; char* ws;
};
#define WSP(T, off) ((T*)(p.ws + (off)))
__device__ __forceinline__ void attn_l0_phase(const Ptrs& p, LDSP char* lds, int bid, int nb) {
    const bf16_t* qkv = WSP(const bf16_t, OFF_QKV); bf16_t* ob = WSP(bf16_t, OFF_OB);
    const int wid = __builtin_amdgcn_readfirstlane(threadIdx.x >> 6);
    for (int u = bid; u < 512 + 1536; u += nb) {
        if (u < 512) { const int head = u & 7, qb = 63 - (u >> 3); sb_unit(qkv, WSP(const bf16_t, OFF_VTA), ob, head, qb, lds); }
        else { const int v = u - 512, kvh = v % 3, qt = v / 3; const int hq = kvh * 8 + wid;
            win_unit<128, true, false>(qkv, ABW, 3072 + hq * 128, 6144 + kvh * 128, WSP(const bf16_t, OFF_VTB) + (size_t)kvh * 128 * S, slope_l0(kvh, wid), p.ab_sinks[hq], 1.f,
                                       (const float*)nullptr, ob, 1024 + hq * 128, qt, lds); }
    }
}
__device__ __forceinline__ void cmp_mlp_phase(const Ptrs& p, LDSP char* lds, int bid, int nb) {
    for (int u = bid; u < 512; u += nb) { const int which = u & 1, kvh = (u >> 1) & 1, grp = u >> 2;
        cmp_mlp_unit(WSP(const bf16_t, OFF_QKV), p.cmp_pos, which ? p.wv1 : p.wk1, which ? p.wv2 : p.wk2, WSP(bf16_t, OFF_KCMP), WSP(bf16_t, OFF_VCMPT), which, kvh, grp, lds); }
}
__device__ __forceinline__ void nsa_cmp_phase(const Ptrs& p, LDSP char* lds, int bid, int nb) {
    for (int u = bid; u < 1024; u += nb) { const int kvh = u & 1, qt = 511 - (u >> 1);
        cmp_unit(WSP(const bf16_t, OFF_QKV), WSP(const bf16_t, OFF_KCMP), WSP(const bf16_t, OFF_VCMPT), WSP(float, OFF_OACC), WSP(int, OFF_IDX), kvh, qt, lds); }
}
__device__ __forceinline__ void nsa_slc_phase(const Ptrs& p, int bid, int nb) {
    const int wid = __builtin_amdgcn_readfirstlane(threadIdx.x >> 6);
    for (int it = bid * 8 + wid; it < S * 2; it += nb * 8) { const int kvh = it & 1, t = it >> 1;
        slc_item(WSP(const bf16_t, OFF_QKV), WSP(const bf16_t, OFF_VTS), WSP(const int, OFF_IDX), WSP(float, OFF_OACC), t, kvh); }
}
__device__ __forceinline__ void nsa_win_phase(const Ptrs& p, LDSP char* lds, int bid, int nb) {
    const bf16_t* qkv = WSP(const bf16_t, OFF_QKV);
    const int wid = __builtin_amdgcn_readfirstlane(threadIdx.x >> 6), r = threadIdx.x & 31;
    for (int u = bid; u < 2048; u += nb) { const int kvh = u & 1, sub = (u >> 1) & 1, qt = u >> 2; const int g = sub * 8 + wid, hq = kvh * 16 + g;
        const float gate = sigmoidf_(bf2f(qkv[(size_t)(qt * 32 + r) * NSWP + 5632 + kvh * 48 + g * 3 + 2]));
        win_unit<512, false, true>(qkv, NSWP, hq * 128, 5120 + kvh * 128, WSP(const bf16_t, OFF_VTW) + (size_t)kvh * 128 * S, slope_l1(kvh, g), 0.f, gate,
                                   WSP(const float, OFF_OACC), WSP(bf16_t, OFF_OB), hq * 128, qt, lds); }
}

constexpr int LDS_GEMM = pg8::STAGE_BYTES;
constexpr int LDS_ATTN = KT_BYTES + VT_BYTES + 32 * 257 * 4 + 64;
constexpr int LDS_CMPM = (144 * 128 + 4 * 9 * 128 + 8 * 128) * 4;
constexpr int LDS_MAX = LDS_GEMM;
extern __shared__ __attribute__((aligned(16))) unsigned char dyn_lds[];
#define LDSB ((LDSP char*)dyn_lds)
template <class Epi> __global__ __launch_bounds__(512, 2) void k_gemm(pg8::Gemm g, Epi E) {
    pg8::StaticOrder So; So.init(g.M, g.N, (int)gridDim.x, (int)blockIdx.x);
    pg8::gemm_phase<Epi, pg8::StaticOrder, false>((PG8_LAS unsigned char*)dyn_lds, g, So, E, nullptr);
}
__global__ __launch_bounds__(512, 2) void k_cvt(CvtJobs js) { cvt_phase(js, LDSB, blockIdx.x, gridDim.x); }
template <bool F32OUT> __global__ __launch_bounds__(512, 2) void k_rmsnorm(const float* x, const float* g, bf16_t* hb, float* hf) { rmsnorm_phase<F32OUT>(x, g, hb, hf, blockIdx.x, gridDim.x); }
__global__ __launch_bounds__(512, 2) void k_vtrans(const bf16_t* src, int ld, int c0, int ncols, bf16_t* dst) { vtrans_phase(src, ld, c0, ncols, dst, LDSB, blockIdx.x, gridDim.x); }
__global__ __launch_bounds__(512, 2) void k_attn_l0(Ptrs p) { attn_l0_phase(p, LDSB, blockIdx.x, gridDim.x); }
__global__ __launch_bounds__(512, 2) void k_cmp_mlp(Ptrs p) { cmp_mlp_phase(p, LDSB, blockIdx.x, gridDim.x); }
__global__ __launch_bounds__(512, 2) void k_nsa_cmp(Ptrs p) { nsa_cmp_phase(p, LDSB, blockIdx.x, gridDim.x); }
__global__ __launch_bounds__(512, 2) void k_nsa_slc(Ptrs p) { nsa_slc_phase(p, blockIdx.x, gridDim.x); }
__global__ __launch_bounds__(512, 2) void k_nsa_win(Ptrs p) { nsa_win_phase(p, LDSB, blockIdx.x, gridDim.x); }
#ifdef SELFTEST
__device__ __forceinline__ unsigned hsh(unsigned x) { x ^= x >> 16; x *= 0x7feb352du; x ^= x >> 15; x *= 0x846ca68bu; x ^= x >> 16; return x; }
__device__ __forceinline__ void dbg_max(float* dbg, int id, float err) { atomicMax((unsigned*)dbg + id, __float_as_uint(fabsf(err))); }
__device__ __forceinline__ int pick_t(int s) {
    switch (s) { case 0: return 0; case 1: return 1; case 2: return 2; case 3: return 30; case 4: return 31; case 5: return 32; case 6: return 47; case 7: return 63; case 8: return 64; case 9: return 65;
                 case 10: return 127; case 11: return 128; case 12: return 511; case 13: return 512; case 14: return 16383; case 15: return 8191; default: break; }
    return (int)(hsh(s * 7919u + 13u) % S); }
__device__ __forceinline__ float dot128(const bf16_t* a, const bf16_t* b) { float s = 0.f; for (int d = 0; d < 128; ++d) s += bf2f(a[d]) * bf2f(b[d]); return s; }
__device__ __forceinline__ float relerr(float got, float ref, float ta, float tr) { return fabsf(got - ref) / (ta + tr * fabsf(ref)); }

__global__ void chk_cvt(CvtJobs js, int njobs, float* dbg, int id) {
    const int s = blockIdx.x * blockDim.x + threadIdx.x; const CvtJob& J = js.j[s % njobs];
    const int rho = hsh(s * 3u + 1u) % J.Nout, k = hsh(s * 5u + 2u) % J.K;
    int col = rho; if (J.mode == 1) { const int pn = rho >> 8, bj = (rho >> 7) & 1, cc = rho & 127; col = bj * DFF + pn * 128 + cc; }
    const float v = col < J.N ? J.src[(size_t)k * J.N + col] : 0.f;
    const bf16_t e = (bf16_t)(pk2(v, 0.f) & 0xffffu), gt = J.dst[(size_t)rho * J.K + k];
    dbg_max(dbg, id, e == gt ? 0.f : 1000.f);
}
__global__ void chk_rmsnorm(const float* x, const float* g, const bf16_t* hb, float* dbg, int id) {
    __shared__ float red[256];
    const int row = pick_t(blockIdx.x), tid = threadIdx.x; float ss = 0.f;
    for (int c = tid; c < DM; c += 256) { const float v = x[(size_t)row * DM + c]; ss += v * v; }
    red[tid] = ss; __syncthreads();
    for (int o = 128; o >= 1; o >>= 1) { if (tid < o) red[tid] += red[tid + o]; __syncthreads(); }
    const float rstd = 1.f / sqrtf(red[0] / DM + EPS);
    for (int c = tid; c < DM; c += 256) dbg_max(dbg, id, relerr(bf2f(hb[(size_t)row * DM + c]), x[(size_t)row * DM + c] * rstd * g[c], 2e-3f, 1e-2f));
}
__global__ void chk_gemm(const bf16_t* A, const bf16_t* Bt, int K, int ncols, int mode, const void* out, int ldo, const float* base, float* dbg, int id) {
    __shared__ float red[2][256];
    const int s = blockIdx.x, tid = threadIdx.x; const int row = pick_t(s), col = (s < 4) ? (s == 0 ? 0 : s == 1 ? ncols - 1 : s == 2 ? 255 : 256) : (int)(hsh(s * 31u + 7u) % ncols);
    int r0 = col, r1 = col; if (mode == 2) { r0 = (col >> 7) * 256 + (col & 127); r1 = r0 + 128; }
    float a0 = 0.f, a1 = 0.f;
    for (int k = tid; k < K; k += 256) { const float av = bf2f(A[(size_t)row * K + k]); a0 += av * bf2f(Bt[(size_t)r0 * K + k]); if (mode == 2) a1 += av * bf2f(Bt[(size_t)r1 * K + k]); }
    red[0][tid] = a0; red[1][tid] = a1; __syncthreads();
    for (int o = 128; o >= 1; o >>= 1) { if (tid < o) { red[0][tid] += red[0][tid + o]; red[1][tid] += red[1][tid + o]; } __syncthreads(); }
    if (tid == 0) { const float d0 = red[0][0], d1 = red[1][0]; float ref, got;
        if (mode == 0) { ref = d0; got = bf2f(((const bf16_t*)out)[(size_t)row * ldo + col]); }
        else if (mode == 1) { ref = base[(size_t)row * ldo + col] + d0; got = ((const float*)out)[(size_t)row * ldo + col]; }
        else { ref = d0 / (1.f + expf(-d0)) * d1; got = bf2f(((const bf16_t*)out)[(size_t)row * ldo + col]); }
        dbg_max(dbg, id, relerr(got, ref, 5e-3f, 1e-2f)); }
}
__global__ void chk_vtrans(const bf16_t* src, int ld, int c0, int ncols, const bf16_t* dst, float* dbg, int id) {
    const int s = blockIdx.x * blockDim.x + threadIdx.x; const int t = hsh(s * 3u + 11u) % S, c = hsh(s * 7u + 5u) % ncols;
    dbg_max(dbg, id, src[(size_t)t * ld + c0 + c] == dst[(size_t)c * S + t] ? 0.f : 1000.f);
}
__global__ void chk_sb(const bf16_t* qkv, const bf16_t* ob, float* scr, float* dbg, int id) {
    const int s = blockIdx.x, tid = threadIdx.x, t = pick_t(s), head = s & 7; float* w = scr + (size_t)s * S;
    const bf16_t* q = qkv + (size_t)t * ABW + head * 128;
    for (int k = tid; k < t; k += 256) w[k] = dot128(q, qkv + (size_t)k * ABW + 1024 + head * 128) * SCALE;
    __syncthreads();
    if (tid == 0) { float run = 0.f; for (int k = t - 1; k >= 0; --k) { const float z = w[k]; run += -(fmaxf(z, 0.f) + log1pf(expf(-fabsf(z)))); w[k] = expf(z + run); } }
    __syncthreads();
    if (tid < 128) { float acc = 0.f; for (int k = 0; k < t; ++k) acc += w[k] * bf2f(qkv[(size_t)k * ABW + 2048 + head * 128 + tid]);
        dbg_max(dbg, id, relerr(bf2f(ob[(size_t)t * DM + head * 128 + tid]), acc, 2e-2f, 2e-2f)); }
}
__global__ void chk_swa(const bf16_t* qkv, const float* sinks, const bf16_t* ob, float* dbg, int id) {
    __shared__ float lg[128]; __shared__ float den_s, m_s;
    const int s = blockIdx.x, tid = threadIdx.x, t = pick_t(s), hq = s % 24, kvh = hq / 8, g = hq % 8;
    const float slope = exp2f(-8.f * (float)(3 * g + kvh + 1) / 24.f);
    const bf16_t* q = qkv + (size_t)t * ABW + 3072 + hq * 128;
    const int k0 = t - 127 > 0 ? t - 127 : 0, nk = t - k0 + 1;
    if (tid < nk) lg[tid] = dot128(q, qkv + (size_t)(k0 + tid) * ABW + 6144 + kvh * 128) * SCALE - slope * (float)(t - k0 - tid);
    __syncthreads();
    if (tid == 0) { float m = sinks[hq]; for (int k = 0; k < nk; ++k) m = fmaxf(m, lg[k]); float den = expf(sinks[hq] - m); for (int k = 0; k < nk; ++k) den += expf(lg[k] - m); den_s = den; m_s = m; }
    __syncthreads();
    if (tid < 128) { float acc = 0.f; for (int k = 0; k < nk; ++k) acc += expf(lg[k] - m_s) / den_s * bf2f(qkv[(size_t)(k0 + k) * ABW + 6528 + kvh * 128 + tid]);
        dbg_max(dbg, id, relerr(bf2f(ob[(size_t)t * DM + 1024 + hq * 128 + tid]), acc, 2e-2f, 2e-2f)); }
}
__global__ void chk_cmpmlp(const bf16_t* qkv, const float* pos, const float* wk1, const float* wk2, const float* wv1, const float* wv2, const bf16_t* kcmp, const bf16_t* vcmpt, float* dbg, int id) {
    __shared__ float hid[128];
    const int s = blockIdx.x, n = threadIdx.x, which = s & 1, kvh = (s >> 1) & 1; const int s4 = s >> 2; const int c = s4 == 0 ? 0 : s4 == 1 ? 1 : s4 == 2 ? 7 : s4 == 3 ? 8 : s4 == 4 ? 1022 : s4 == 5 ? 1023 : (int)(hsh(s * 17u + 3u) % 1024);
    const float* w1 = which ? wv1 : wk1; const float* w2 = which ? wv2 : wk2; const int scol = (which ? 4352 : 4096) + kvh * 128;
    float a = 0.f;
    if (c < NCMP) for (int l = 0; l < 32; ++l) for (int d = 0; d < 128; ++d) a += (bf2f(qkv[(size_t)(16 * c + l) * NSWP + scol + d]) + pos[l * 128 + d]) * w1[(size_t)(l * 128 + d) * 128 + n];
    const float u = 0.7978845608028654f * (a + 0.044715f * a * a * a); hid[n] = 0.5f * a * (1.f + tanhf(u)); __syncthreads();
    float o = 0.f; for (int k = 0; k < 128; ++k) o += hid[k] * w2[k * 128 + n]; if (c >= NCMP) o = 0.f;
    const float got = which ? bf2f(vcmpt[((size_t)kvh * 128 + n) * NCMPP + c]) : bf2f(kcmp[((size_t)kvh * NCMPP + c) * 128 + n]);
    dbg_max(dbg, id, relerr(got, o, 3e-3f, 1e-2f));
}
__global__ void chk_idx(const bf16_t* qkv, const bf16_t* kcmp, const int* idx, float* dbg, int id) {
    __shared__ float sc[1024]; __shared__ float imp[256]; __shared__ float ms[2]; __shared__ float scr_[256]; __shared__ int taken[256]; __shared__ int seen[256];
    const int s = blockIdx.x, tid = threadIdx.x, t = pick_t(s), kvh = s & 1;
    imp[tid] = 0.f; __syncthreads();
    for (int g = 0; g < 16; ++g) { const int hq = kvh * 16 + g; const float slope = exp2f(-8.f * (float)(2 * g + kvh + 1) / 32.f);
        const bf16_t* q = qkv + (size_t)t * NSWP + hq * 128;
        for (int c = tid; c < 1024; c += 256) { const int dist = t - 16 * c - 31; sc[c] = (c < NCMP && dist >= 0) ? dot128(q, kcmp + ((size_t)kvh * NCMPP + c) * 128) * SCALE - slope * (float)dist : -1e30f; }
        __syncthreads();
        if (tid == 0) { float m = -1e30f; for (int c = 0; c < NCMP; ++c) m = fmaxf(m, sc[c]); float den = 0.f; for (int c = 0; c < NCMP; ++c) den += sc[c] > -1e29f ? expf(sc[c] - m) : 0.f; ms[0] = m; ms[1] = fmaxf(den, 1e-30f); }
        __syncthreads();
        for (int c = tid; c < 1024; c += 256) sc[c] = sc[c] > -1e29f ? expf(sc[c] - ms[0]) / ms[1] : 0.f;
        __syncthreads();
        { float a = 0.f; for (int c = 4 * tid - 1; c <= 4 * tid + 3; ++c) if (c >= 0 && c < NCMP) a += sc[c]; imp[tid] += a; }
        __syncthreads(); }
    if (tid == 0) { const int cur = t >> 6; float thr = 0.f;
        for (int j = 0; j < 256; ++j) { const bool forced = j == 0 || j == cur || j == cur - 1; scr_[j] = j <= cur ? imp[j] + (forced ? 1e4f : 0.f) : -1e30f; taken[j] = 0; }
        for (int rd = 0; rd < 8; ++rd) { int bj = -1; float bs = -3e38f; for (int j = 0; j < 256; ++j) if (!taken[j] && scr_[j] > bs) { bs = scr_[j]; bj = j; } taken[bj] = 1; thr = bs; }
        float err = 0.f; for (int j = 0; j < 256; ++j) seen[j] = 0;
        for (int b = 0; b < 8; ++b) { const int jf = idx[((size_t)t * 2 + kvh) * 8 + b];
            if (jf < 0 || jf > 255 || seen[jf]) { err = 2000.f; continue; } seen[jf] = 1;
            if (!taken[jf] && !(scr_[jf] >= thr - 0.02f * fabsf(thr) - 1e-6f)) err = fmaxf(err, 1000.f); }
        dbg_max(dbg, id, err); }
}
__global__ void chk_nsa(const bf16_t* qkv, const bf16_t* kcmp, const bf16_t* vcmpt, const int* idx, const bf16_t* ob, float* dbg, int id) {
    __shared__ float sc[1024]; __shared__ float ms[2];
    const int s = blockIdx.x, tid = threadIdx.x, t = pick_t(s), hq = s & 31, kvh = hq >> 4, g = hq & 15;
    const float slope = exp2f(-8.f * (float)(2 * g + kvh + 1) / 32.f);
    const bf16_t* q = qkv + (size_t)t * NSWP + hq * 128;
    float oc = 0.f, os = 0.f, ow = 0.f;
    for (int c = tid; c < 1024; c += 256) { const int dist = t - 16 * c - 31; sc[c] = (c < NCMP && dist >= 0) ? dot128(q, kcmp + ((size_t)kvh * NCMPP + c) * 128) * SCALE - slope * (float)dist : -1e30f; }
    __syncthreads();
    if (tid == 0) { float m = -1e30f; for (int c = 0; c < 1024; ++c) m = fmaxf(m, sc[c]); float den = 0.f; for (int c = 0; c < 1024; ++c) den += sc[c] > -1e29f ? expf(sc[c] - m) : 0.f; ms[0] = m; ms[1] = fmaxf(den, 1e-30f); }
    __syncthreads();
    if (tid < 128) for (int c = 0; c < NCMP; ++c) if (sc[c] > -1e29f) oc += expf(sc[c] - ms[0]) / ms[1] * bf2f(vcmpt[((size_t)kvh * 128 + tid) * NCMPP + c]);
    __syncthreads();
    for (int e = tid; e < 512; e += 256) { const int pos = idx[((size_t)t * 2 + kvh) * 8 + (e >> 6)] * 64 + (e & 63); const int dist = t - pos;
        sc[e] = dist >= 0 ? dot128(q, qkv + (size_t)pos * NSWP + 4608 + kvh * 128) * SCALE - slope * (float)dist : -1e30f; }
    __syncthreads();
    if (tid == 0) { float m = -1e30f; for (int c = 0; c < 512; ++c) m = fmaxf(m, sc[c]); float den = 0.f; for (int c = 0; c < 512; ++c) den += sc[c] > -1e29f ? expf(sc[c] - m) : 0.f; ms[0] = m; ms[1] = fmaxf(den, 1e-30f); }
    __syncthreads();
    if (tid < 128) for (int e = 0; e < 512; ++e) if (sc[e] > -1e29f) { const int pos = idx[((size_t)t * 2 + kvh) * 8 + (e >> 6)] * 64 + (e & 63); os += expf(sc[e] - ms[0]) / ms[1] * bf2f(qkv[(size_t)pos * NSWP + 4864 + kvh * 128 + tid]); }
    __syncthreads();
    const int k0 = t - 511 > 0 ? t - 511 : 0, nk = t - k0 + 1;
    for (int e = tid; e < nk; e += 256) sc[e] = dot128(q, qkv + (size_t)(k0 + e) * NSWP + 5120 + kvh * 128) * SCALE - slope * (float)(t - k0 - e);
    __syncthreads();
    if (tid == 0) { float m = -1e30f; for (int c = 0; c < nk; ++c) m = fmaxf(m, sc[c]); float den = 0.f; for (int c = 0; c < nk; ++c) den += expf(sc[c] - m); ms[0] = m; ms[1] = den; }
    __syncthreads();
    if (tid < 128) { for (int e = 0; e < nk; ++e) ow += expf(sc[e] - ms[0]) / ms[1] * bf2f(qkv[(size_t)(k0 + e) * NSWP + 5376 + kvh * 128 + tid]);
        const bf16_t* gp = qkv + (size_t)t * NSWP + 5632 + kvh * 48 + g * 3;
        const float g0 = 1.f / (1.f + expf(-bf2f(gp[0]))), g1 = 1.f / (1.f + expf(-bf2f(gp[1]))), g2 = 1.f / (1.f + expf(-bf2f(gp[2])));
        dbg_max(dbg, id, relerr(bf2f(ob[(size_t)t * DM + hq * 128 + tid]), g0 * oc + g1 * os + g2 * ow, 2e-2f, 2e-2f)); }
}
constexpr int NCHK = 16;
__global__ void k_report(const float* dbg, float* out) {
    if (threadIdx.x == 0 && blockIdx.x == 0) { float v = 1000.f; for (int i = 0; i < NCHK; ++i) { if (!(dbg[i] <= 1.0f)) { out[0] = v; break; } v *= 10.f; } }
}
#endif
static int g_cus = 0;
template <class K> static void set_lds(K kern, int bytes) { hipError_t e = hipFuncSetAttribute((const void*)kern, hipFuncAttributeMaxDynamicSharedMemorySize, bytes); if (e != hipSuccess) fprintf(stderr, "hipFuncSetAttribute: %s\n", hipGetErrorString(e)); }
template <class Epi> static void run_gemm(const bf16_t* A, const bf16_t* Bt, int M, int N, int K, const Epi& E, hipStream_t st) {
    static bool once = false; if (!once) { set_lds(k_gemm<Epi>, LDS_GEMM); once = true; }
    pg8::Gemm g{A, Bt, M, N, K, 0};
    hipLaunchKernelGGL((k_gemm<Epi>), dim3(g_cus), dim3(512), LDS_GEMM, st, g, E);
}
extern "C" void kernel_launch(void* const* d_in, const int* in_sizes, int n_in, void* d_out, int out_size, void* d_ws, size_t ws_size, hipStream_t stream) {
    (void)in_sizes; (void)out_size;
    if (n_in != 16 || ws_size < WS_NEED) { fprintf(stderr, "kernel_launch: bad arguments (n_in %d, ws %zu, need %zu)\n", n_in, ws_size, (size_t)WS_NEED); return; }
    static bool init = false;
    if (!init) { init = true; int dev = 0; (void)hipGetDevice(&dev); if (hipDeviceGetAttribute(&g_cus, hipDeviceAttributeMultiprocessorCount, dev) != hipSuccess || g_cus <= 0) g_cus = 256;
        set_lds(k_cvt, 64 * 65 * 4); set_lds(k_vtrans, 64 * 72 * 2); set_lds(k_attn_l0, LDS_ATTN); set_lds(k_cmp_mlp, LDS_CMPM); set_lds(k_nsa_cmp, LDS_ATTN); set_lds(k_nsa_win, LDS_ATTN); }
    Ptrs p{};
    p.x = (const float*)d_in[0]; p.attn_norm = (const float*)d_in[1]; p.ffn_norm = (const float*)d_in[2]; p.w_gate_up = (const float*)d_in[3]; p.w_down = (const float*)d_in[4];
    p.ab_w_in = (const float*)d_in[5]; p.ab_sinks = (const float*)d_in[6]; p.ab_w_out = (const float*)d_in[7]; p.nsa_w_in = (const float*)d_in[8]; p.cmp_pos = (const float*)d_in[9];
    p.wk1 = (const float*)d_in[10]; p.wk2 = (const float*)d_in[11]; p.wv1 = (const float*)d_in[12]; p.wv2 = (const float*)d_in[13]; p.nsa_w_out = (const float*)d_in[14]; p.final_norm = (const float*)d_in[15];
    p.out = (float*)d_out; p.ws = (char*)d_ws;
    const int G = g_cus; const dim3 blk(512);
    bf16_t *wt_abin = WSP(bf16_t, OFF_WT_ABIN), *wt_about = WSP(bf16_t, OFF_WT_ABOUT), *wt_gu0 = WSP(bf16_t, OFF_WT_GU0), *wt_gu1 = WSP(bf16_t, OFF_WT_GU1), *wt_dn0 = WSP(bf16_t, OFF_WT_DN0), *wt_dn1 = WSP(bf16_t, OFF_WT_DN1),
           *wt_nsin = WSP(bf16_t, OFF_WT_NSIN), *wt_nsout = WSP(bf16_t, OFF_WT_NSOUT), *hb = WSP(bf16_t, OFF_HB), *ob = WSP(bf16_t, OFF_OB), *qkv = WSP(bf16_t, OFF_QKV), *hid = WSP(bf16_t, OFF_HID);
    float *x1 = WSP(float, OFF_X1), *x2 = WSP(float, OFF_X2);
    CvtJobs js{};
    { const float* srcs[NCVT] = {p.ab_w_in, p.ab_w_out, p.w_gate_up, p.w_gate_up + (size_t)DM * 2 * DFF, p.w_down, p.w_down + (size_t)DFF * DM, p.nsa_w_in, p.nsa_w_out};
      bf16_t* dsts[NCVT] = {wt_abin, wt_about, wt_gu0, wt_gu1, wt_dn0, wt_dn1, wt_nsin, wt_nsout};
      const int Ks[NCVT] = {DM, DM, DM, DM, DFF, DFF, DM, DM}, Ns[NCVT] = {ABW, DM, 2 * DFF, 2 * DFF, DM, DM, NSW, DM}, No[NCVT] = {ABW, DM, 2 * DFF, 2 * DFF, DM, DM, NSWP, DM}, md[NCVT] = {0, 0, 1, 1, 0, 0, 0, 0};
      int t0 = 0; for (int i = 0; i < NCVT; ++i) { js.j[i] = CvtJob{srcs[i], dsts[i], Ks[i], Ns[i], No[i], md[i], t0, No[i] / 64}; t0 += (No[i] / 64) * (Ks[i] / 64); } js.total = t0; }
#ifdef SELFTEST
    float* dbg = WSP(float, OFF_DBG); float* scr = WSP(float, OFF_SCR);
    (void)hipMemsetAsync(dbg, 0, 256, stream);
#define CHK(...) __VA_ARGS__
#else
#define CHK(...)
#endif
    hipLaunchKernelGGL(k_cvt, dim3(G * 4), blk, 64 * 65 * 4, stream, js);
    CHK(hipLaunchKernelGGL(chk_cvt, dim3(64), dim3(256), 0, stream, js, NCVT, dbg, 0);)
    hipLaunchKernelGGL(k_rmsnorm<false>, dim3(G), blk, 0, stream, p.x, p.attn_norm, hb, (float*)nullptr);
    CHK(hipLaunchKernelGGL(chk_rmsnorm, dim3(64), dim3(256), 0, stream, p.x, p.attn_norm, hb, dbg, 1);)
    run_gemm(hb, wt_abin, S, ABW, DM, EpiBf16{qkv, ABW, 0}, stream);
    CHK(hipLaunchKernelGGL(chk_gemm, dim3(256), dim3(256), 0, stream, hb, wt_abin, DM, ABW, 0, (const void*)qkv, ABW, (const float*)nullptr, dbg, 2);)
    hipLaunchKernelGGL(k_vtrans, dim3(G * 2), blk, 64 * 72 * 2, stream, qkv, ABW, 2048, 1024, WSP(bf16_t, OFF_VTA));
    hipLaunchKernelGGL(k_vtrans, dim3(G * 2), blk, 64 * 72 * 2, stream, qkv, ABW, 6528, 384, WSP(bf16_t, OFF_VTB));
    CHK(hipLaunchKernelGGL(chk_vtrans, dim3(16), dim3(256), 0, stream, qkv, ABW, 2048, 1024, WSP(bf16_t, OFF_VTA), dbg, 3);)
    CHK(hipLaunchKernelGGL(chk_vtrans, dim3(16), dim3(256), 0, stream, qkv, ABW, 6528, 384, WSP(bf16_t, OFF_VTB), dbg, 3);)
    hipLaunchKernelGGL(k_attn_l0, dim3(G), blk, LDS_ATTN, stream, p);
    CHK(hipLaunchKernelGGL(chk_sb, dim3(96), dim3(256), 0, stream, qkv, ob, scr, dbg, 4);)
    CHK(hipLaunchKernelGGL(chk_swa, dim3(192), dim3(256), 0, stream, qkv, p.ab_sinks, ob, dbg, 5);)
    run_gemm(ob, wt_about, S, DM, DM, EpiRes{p.x, x1, DM, 0}, stream);
    CHK(hipLaunchKernelGGL(chk_gemm, dim3(256), dim3(256), 0, stream, ob, wt_about, DM, DM, 1, (const void*)x1, DM, p.x, dbg, 6);)
    hipLaunchKernelGGL(k_rmsnorm<false>, dim3(G), blk, 0, stream, x1, p.ffn_norm, hb, (float*)nullptr);
    run_gemm(hb, wt_gu0, S, 2 * DFF, DM, EpiSwiGLU{hid, DFF, 0}, stream);
    CHK(hipLaunchKernelGGL(chk_gemm, dim3(256), dim3(256), 0, stream, hb, wt_gu0, DM, DFF, 2, (const void*)hid, DFF, (const float*)nullptr, dbg, 7);)
    run_gemm(hid, wt_dn0, S, DM, DFF, EpiRes{x1, x2, DM, 0}, stream);
    CHK(hipLaunchKernelGGL(chk_gemm, dim3(256), dim3(256), 0, stream, hid, wt_dn0, DFF, DM, 1, (const void*)x2, DM, x1, dbg, 8);)
    hipLaunchKernelGGL(k_rmsnorm<false>, dim3(G), blk, 0, stream, x2, p.attn_norm + DM, hb, (float*)nullptr);
    run_gemm(hb, wt_nsin, S, NSWP, DM, EpiBf16{qkv, NSWP, 0}, stream);
    CHK(hipLaunchKernelGGL(chk_gemm, dim3(256), dim3(256), 0, stream, hb, wt_nsin, DM, NSWP, 0, (const void*)qkv, NSWP, (const float*)nullptr, dbg, 9);)
    hipLaunchKernelGGL(k_cmp_mlp, dim3(G), blk, LDS_CMPM, stream, p);
    CHK(hipLaunchKernelGGL(chk_cmpmlp, dim3(256), dim3(128), 0, stream, qkv, p.cmp_pos, p.wk1, p.wk2, p.wv1, p.wv2, WSP(bf16_t, OFF_KCMP), WSP(bf16_t, OFF_VCMPT), dbg, 10);)
    hipLaunchKernelGGL(k_vtrans, dim3(G), blk, 64 * 72 * 2, stream, qkv, NSWP, 4864, 256, WSP(bf16_t, OFF_VTS));
    hipLaunchKernelGGL(k_vtrans, dim3(G), blk, 64 * 72 * 2, stream, qkv, NSWP, 5376, 256, WSP(bf16_t, OFF_VTW));
    hipLaunchKernelGGL(k_nsa_cmp, dim3(G), blk, LDS_ATTN, stream, p);
    CHK(hipLaunchKernelGGL(chk_idx, dim3(192), dim3(256), 0, stream, qkv, WSP(bf16_t, OFF_KCMP), WSP(int, OFF_IDX), dbg, 11);)
    hipLaunchKernelGGL(k_nsa_slc, dim3(G), blk, 0, stream, p);
    hipLaunchKernelGGL(k_nsa_win, dim3(G), blk, LDS_ATTN, stream, p);
    CHK(hipLaunchKernelGGL(chk_nsa, dim3(256), dim3(256), 0, stream, qkv, WSP(bf16_t, OFF_KCMP), WSP(bf16_t, OFF_VCMPT), WSP(int, OFF_IDX), ob, dbg, 12);)
    run_gemm(ob, wt_nsout, S, DM, DM, EpiRes{x2, x1, DM, 0}, stream);
    hipLaunchKernelGGL(k_rmsnorm<false>, dim3(G), blk, 0, stream, x1, p.ffn_norm + DM, hb, (float*)nullptr);
    run_gemm(hb, wt_gu1, S, 2 * DFF, DM, EpiSwiGLU{hid, DFF, 0}, stream);
    run_gemm(hid, wt_dn1, S, DM, DFF, EpiRes{x1, x2, DM, 0}, stream);
    hipLaunchKernelGGL(k_rmsnorm<true>, dim3(G), blk, 0, stream, x2, p.final_norm, (bf16_t*)nullptr, p.out);
    CHK(hipLaunchKernelGGL(k_report, dim3(1), dim3(64), 0, stream, dbg, p.out);)
}
```

```cpp
#include <hip/hip_runtime.h>
#include <stdint.h>
#include <stdio.h>
__device__ __forceinline__ int tid_l() { int t = (int)threadIdx.x; asm volatile("" : "+v"(t)); return t; }
#define XB_TMO      128
#define XB_XCNT(j)  (256  + 64 * (j))
#define XB_XSUB(j)  (1280 + 64 * (j))
#define XB_XGEN(j)  (2304 + 64 * (j))
#define XB_TOP      3328
#define XB_TOPGEN   3392
#define XCD_BAR_WORDS 3456
#define XB_SPIN_CAP (1u << 18)
#define LAS __attribute__((address_space(3)))

__device__ __forceinline__ unsigned xb_ld(unsigned* p)              { return __hip_atomic_load(p, __ATOMIC_RELAXED, __HIP_MEMORY_SCOPE_AGENT); }
__device__ __forceinline__ unsigned xb_add(unsigned* p, unsigned v) { return __hip_atomic_fetch_add(p, v, __ATOMIC_RELAXED, __HIP_MEMORY_SCOPE_AGENT); }
__device__ __forceinline__ unsigned xb_xcc_id() { return (unsigned)__builtin_amdgcn_s_getreg((3 << 11) | 20) & 0xFu; }
#define XB_SPIN(cond, bar) do { unsigned _sp = 0; while (cond) { __builtin_amdgcn_s_sleep(1); \
    if ((++_sp & 255u) == 0u) { if (xb_ld(&(bar)[XB_TMO])) break; if (_sp > XB_SPIN_CAP) { atomicAdd(&(bar)[XB_TMO], 1u); break; } } } } while (0)

struct XcdBarrier {
    unsigned* bar; unsigned x;
    volatile LAS unsigned* st;
};

__device__ __forceinline__ XcdBarrier xcd_barrier_post(unsigned* bar, volatile LAS unsigned* st) {
    XcdBarrier b; b.bar = bar; b.x = xb_xcc_id(); b.st = st;
    if (threadIdx.x == 0) (void)xb_add(&bar[XB_XCNT(b.x)], 1u);
    return b;
}
__device__ __forceinline__ void xcd_barrier_complete(unsigned* bar, unsigned x, unsigned& nloc, unsigned& nx) {
    const unsigned G = gridDim.x * gridDim.y * gridDim.z;
    unsigned sum, cnt, mine, sp = 0u;
    for (;;) {
        sum = 0u; cnt = 0u; mine = 0u;
#pragma unroll
        for (unsigned j = 0; j < 16; ++j) { const unsigned c = xb_ld(&bar[XB_XCNT(j)]); sum += c; cnt += (c > 0u) ? 1u : 0u; mine = (j == x) ? c : mine; }
        if (sum == G) break;
        __builtin_amdgcn_s_sleep(1);
        if ((++sp & 255u) == 0u) { if (xb_ld(&bar[XB_TMO])) break; if (sp > XB_SPIN_CAP) { atomicAdd(&bar[XB_TMO], 1u); break; } }
    }
    nloc = mine > 0u ? mine : 1u; nx = cnt > 0u ? cnt : 1u;
}

__device__ __forceinline__ void xcd_barrier(const XcdBarrier& b) {
    asm volatile("s_waitcnt vmcnt(0)" ::: "memory");
    __syncthreads();
    if (threadIdx.x == 0) {
        unsigned* bar = b.bar;
        __builtin_amdgcn_s_waitcnt(0);
        unsigned nloc = b.st[0], nx = b.st[1];
        if (nloc == 0u) { xcd_barrier_complete(bar, b.x, nloc, nx); b.st[0] = nloc; b.st[1] = nx; }
        const unsigned old = xb_add(&bar[XB_XSUB(b.x)], 1u);
        const unsigned gen = old / nloc;
        if (old + 1u == (gen + 1u) * nloc) {
            __builtin_amdgcn_fence(__ATOMIC_RELEASE, "agent");
            asm volatile("s_waitcnt vmcnt(0)" ::: "memory");
            const unsigned og = xb_add(&bar[XB_TOP], 1u);
            const unsigned tg = og / nx;
            if (og + 1u == (tg + 1u) * nx) xb_add(&bar[XB_TOPGEN], 1u);
            else XB_SPIN(xb_ld(&bar[XB_TOPGEN]) == tg, bar);
            __builtin_amdgcn_fence(__ATOMIC_ACQUIRE, "agent");
            xb_add(&bar[XB_XGEN(b.x)], 1u);
            asm volatile("s_waitcnt vmcnt(0)" ::: "memory");
        } else {
            XB_SPIN(xb_ld(&bar[XB_XGEN(b.x)]) == gen, bar);
            __builtin_amdgcn_fence(__ATOMIC_ACQUIRE, "agent");
            asm volatile("s_waitcnt vmcnt(0)" ::: "memory");
        }
    }
    __syncthreads();
}

namespace pg8 {
#define PG8_LAS __attribute__((address_space(3)))
typedef unsigned short bf16_t;
typedef short bf16x8 __attribute__((ext_vector_type(8)));
typedef float f32x4 __attribute__((ext_vector_type(4)));
typedef unsigned u32x4 __attribute__((ext_vector_type(4)));
constexpr int BM = 256, BK = 64, HALF = 128, HTB = HALF * BK * 2  , STAGE_BYTES = 8 * HTB, NXCD = 8, WGM = 8;

__host__ __device__ __forceinline__ int lds_byte(int r, int c) { const int st = (r >> 4) * 2 + (c >> 5), rr = r & 15, cc = c & 31, ob = rr * 64 + cc * 2; return st * 1024 + (ob ^ (((ob >> 9) & 1) << 5)); }
__host__ __device__ __forceinline__ void stage_rc(int b, int& R, int& C) { const int st = b / 1024, sb = b % 1024, swz = sb ^ (((sb >> 9) & 1) << 5); R = (st >> 1) * 16 + swz / 64; C = (st & 1) * 32 + (swz % 64) / 2; }
__host__ __device__ __forceinline__ int perm32(int rho) { const int n = rho >> 4, i = rho & 15; return 8 * (i >> 2) + 4 * n + (i & 3); }

struct Unit { int pm, pn; };
struct Gemm { const bf16_t* A; const bf16_t* Bt; int M, N, K, tiled; };

struct StaticOrder {
    int nM, nN, nwg, G, c;
    __host__ __device__ void init(int M, int N, int G_, int c_) { nM = M / BM; nN = N / BM; nwg = nM * nN; G = G_; c = c_; }
    __host__ __device__ bool next(int i, Unit& u) const {
        const long L = (long)i * G + c; if (L >= nwg) return false;
        int wgid = (int)L; { const int q = nwg / NXCD, r = nwg % NXCD, xcd = wgid % NXCD, off = wgid / NXCD; wgid = (xcd < r ? xcd * (q + 1) : r * (q + 1) + (xcd - r) * q) + off; }
        const int nig = WGM * nN, gid = wgid / nig, fm = gid * WGM, gsz = (nM - fm) < WGM ? (nM - fm) : WGM;
        u.pm = fm + ((wgid % nig) % gsz); u.pn = (wgid % nig) / gsz; return true;
    }
    __device__ __forceinline__ void a_ready(const Unit&) const {}
    __device__ __forceinline__ void done(const Unit&) const {}
};
__device__ __forceinline__ unsigned cvt_pk_bf16(float lo, float hi) { unsigned r; asm volatile("v_cvt_pk_bf16_f32 %0, %1, %2" : "=v"(r) : "v"(lo), "v"(hi)); return r; }
typedef float f32x2 __attribute__((ext_vector_type(2)));
template <class Epi, class Sched, bool STAMP = false>
__device__ __forceinline__ void gemm_phase(PG8_LAS unsigned char* lds, const Gemm g, const Sched& S, const Epi& E, unsigned long long* stamps) {
    const int tid = tid_l(), wid = __builtin_amdgcn_readfirstlane(tid >> 6), lane = tid & 63, wr = wid >> 2, wc = wid & 3, fr = lane & 15, fq = lane >> 4;
    const int K = g.K, nt = K / BK;
    int ts_lo = 0, ts_hi = 0, nts = 0; const unsigned long long rt_entry = STAMP ? (unsigned long long)wall_clock64() : 0ull;
#define PG8_STAMP() do { if (STAMP && wid == 0 && nts < 64) { const unsigned long long _c = (unsigned long long)clock64(); \
        ts_lo = (lane == nts) ? (int)(unsigned)_c : ts_lo; ts_hi = (lane == nts) ? (int)(unsigned)(_c >> 32) : ts_hi; ++nts; } } while (0)
    PG8_STAMP();
    unsigned voffA[2], voffB[2];
#pragma unroll
    for (int i = 0; i < 2; ++i) { int R, C; stage_rc(tid * 16 + i * 8192, R, C); const int Rb = Epi::PERM ? ((R & ~31) + perm32(R & 31)) : R;
        voffA[i] = (unsigned)(R * ((g.tiled & 1) ? 64 : K) + C) * 2u; voffB[i] = (unsigned)(Rb * ((g.tiled & 2) ? 64 : K) + C) * 2u; }
    const size_t tstep = (size_t)BM * K * 2;
    const size_t akstep = (g.tiled & 1) ? (size_t)BM * BK * 2 : (size_t)(BK * 2), bkstep = (g.tiled & 2) ? (size_t)BM * BK * 2 : (size_t)(BK * 2);
    const size_t ahstep = (g.tiled & 1) ? (size_t)HALF * BK * 2 : (size_t)HALF * K * 2, bhstep = (g.tiled & 2) ? (size_t)HALF * BK * 2 : (size_t)HALF * K * 2;
    const unsigned ldsw = (unsigned)wid * 1024u;
    const int aoff = lds_byte(wr * 64 + fr, fq * 8), boff = lds_byte(wc * 32 + fr, fq * 8);
#define PG8_SA(b, h) (((b) * 2 + (h)) * HTB)
#define PG8_SB(b, h) ((4 + (b) * 2 + (h)) * HTB)
#define PG8_STAGE(bufoff, gbase, voff) do { _Pragma("unroll") for (int _i = 0; _i < 2; ++_i) \
        __builtin_amdgcn_global_load_lds((const unsigned*)((const char*)(gbase) + (voff)[_i]), (PG8_LAS unsigned*)(lds + (bufoff) + ldsw + _i * 8192), 16, 0, 0); } while (0)
#define PG8_LDA(dst, b, h) do { _Pragma("unroll") for (int m = 0; m < 4; ++m) _Pragma("unroll") for (int k = 0; k < 2; ++k) dst[m][k] = *(const PG8_LAS bf16x8*)(lds + PG8_SA(b, h) + aoff + m * 2048 + k * 1024); } while (0)
#define PG8_LDB(dst, b, h) do { _Pragma("unroll") for (int n = 0; n < 2; ++n) _Pragma("unroll") for (int k = 0; k < 2; ++k) dst[n][k] = *(const PG8_LAS bf16x8*)(lds + PG8_SB(b, h) + boff + n * 2048 + k * 1024); } while (0)
#define PG8_MMA(ai, bj, At, Bt) do { __builtin_amdgcn_s_setprio(1); _Pragma("unroll") for (int m = 0; m < 4; ++m) _Pragma("unroll") for (int n = 0; n < 2; ++n) _Pragma("unroll") for (int k = 0; k < 2; ++k) \
        acc[ai][bj][m][n] = __builtin_amdgcn_mfma_f32_16x16x32_bf16(Bt[n][k], At[m][k], acc[ai][bj][m][n], 0, 0, 0); __builtin_amdgcn_s_setprio(0); } while (0)
#define PG8_WAIT_V(n) asm volatile("s_waitcnt vmcnt(" #n ")" ::: "memory")
#define PG8_WAIT_L(n) asm volatile("s_waitcnt lgkmcnt(" #n ")" ::: "memory")
#define PG8_BAR __builtin_amdgcn_s_barrier()
#define PG8_SCHED __builtin_amdgcn_sched_barrier(0)
    Unit cur, nxt; int ui = 0;
    if (!S.next(0, cur)) return;
    f32x4 acc[2][2][4][2];
#pragma unroll
    for (int a = 0; a < 2; ++a)
#pragma unroll
        for (int b = 0; b < 2; ++b)
#pragma unroll
            for (int m = 0; m < 4; ++m)
#pragma unroll
                for (int n = 0; n < 2; ++n) acc[a][b][m][n] = (f32x4){0.f, 0.f, 0.f, 0.f};
    bf16x8 At[4][2], B0[2][2], B1[2][2];
    const char* cA = (const char*)g.A + (size_t)cur.pm * tstep; const char* cB = (const char*)g.Bt + (size_t)cur.pn * tstep;
    S.a_ready(cur);
    PG8_STAGE(PG8_SB(0, 0), cB, voffB); PG8_STAGE(PG8_SA(0, 0), cA, voffA); PG8_STAGE(PG8_SB(0, 1), cB + bhstep, voffB); PG8_STAGE(PG8_SA(0, 1), cA + ahstep, voffA);
    if (wr == 1) PG8_BAR;
    PG8_WAIT_V(4); PG8_BAR;
    PG8_STAGE(PG8_SB(1, 0), cB + bkstep, voffB); PG8_STAGE(PG8_SA(1, 0), cA + akstep, voffA); PG8_STAGE(PG8_SB(1, 1), cB + bhstep + bkstep, voffB);
    PG8_WAIT_V(6); PG8_BAR;
    PG8_STAMP();
    for (;;) {
        const bool has_next = S.next(ui + 1, nxt);
        const char* nA = has_next ? (const char*)g.A + (size_t)nxt.pm * tstep : cA; const char* nB = has_next ? (const char*)g.Bt + (size_t)nxt.pn * tstep : cB;
        for (int t = 0; t < nt; t += 2) {
            const bool last = (t == nt - 2);
            const char* a1 = cA + (size_t)(t + 1) * akstep;
            const char* a2 = last ? nA : cA + (size_t)(t + 2) * akstep; const char* b2 = last ? nB : cB + (size_t)(t + 2) * bkstep;
            const char* a3 = a2 + akstep; const char* b3 = b2 + bkstep;
            if (last && has_next) S.a_ready(nxt);
            PG8_LDB(B0, 0, 0); PG8_SCHED; PG8_LDA(At, 0, 0); PG8_STAGE(PG8_SA(1, 1), a1 + ahstep, voffA);
            PG8_WAIT_L(8); PG8_BAR; PG8_WAIT_L(0); PG8_MMA(0, 0, At, B0); PG8_BAR; PG8_SCHED;
            PG8_LDB(B1, 0, 1); PG8_STAGE(PG8_SB(0, 0), b2, voffB);
            PG8_BAR; PG8_WAIT_L(0); PG8_MMA(0, 1, At, B1); PG8_BAR;
            PG8_LDA(At, 0, 1); PG8_STAGE(PG8_SA(0, 0), a2, voffA);
            PG8_BAR; PG8_WAIT_L(0); PG8_MMA(1, 0, At, B0); PG8_BAR; PG8_SCHED;
            PG8_STAGE(PG8_SB(0, 1), b2 + bhstep, voffB);
            PG8_WAIT_V(6); PG8_BAR; PG8_MMA(1, 1, At, B1); PG8_BAR;
            PG8_LDB(B0, 1, 0); PG8_SCHED; PG8_LDA(At, 1, 0); PG8_STAGE(PG8_SA(0, 1), a2 + ahstep, voffA);
            PG8_WAIT_L(8); PG8_BAR; PG8_WAIT_L(0); PG8_MMA(0, 0, At, B0); PG8_BAR; PG8_SCHED;
            PG8_LDB(B1, 1, 1); PG8_STAGE(PG8_SB(1, 0), b3, voffB);
            PG8_BAR; PG8_WAIT_L(0); PG8_MMA(0, 1, At, B1); PG8_BAR;
            PG8_LDA(At, 1, 1); PG8_STAGE(PG8_SA(1, 0), a3, voffA);
            PG8_BAR; PG8_WAIT_L(0); PG8_MMA(1, 0, At, B0); PG8_BAR; PG8_SCHED;
            PG8_STAGE(PG8_SB(1, 1), b3 + bhstep, voffB);
            PG8_WAIT_V(6); PG8_BAR; PG8_MMA(1, 1, At, B1); PG8_BAR;
        }
        PG8_STAMP();
        if constexpr (!Epi::AFTER_DRAIN) { E(acc, cur, wr, wc, fr, fq); S.done(cur); }
        PG8_STAMP();
        if (!has_next) break;
#pragma unroll
        for (int a = 0; a < 2; ++a)
#pragma unroll
            for (int b = 0; b < 2; ++b)
#pragma unroll
                for (int m = 0; m < 4; ++m)
#pragma unroll
                    for (int n = 0; n < 2; ++n) acc[a][b][m][n] = (f32x4){0.f, 0.f, 0.f, 0.f};
        cur = nxt; cA = nA; cB = nB; ++ui;
    }
    PG8_WAIT_V(0);
    if (wr == 0) PG8_BAR;
    PG8_BAR;
    if constexpr (Epi::AFTER_DRAIN) { E.fused(acc, cur, wr, wc, fr, fq, lds, wid, lane); S.done(cur); }
    PG8_STAMP();
    if (STAMP && wid == 0) { stamps[lane] = lane < nts ? (((unsigned long long)(unsigned)ts_hi << 32) | (unsigned)ts_lo) : 0ull;
        if (lane == 62) stamps[62] = rt_entry; if (lane == 63) stamps[63] = (unsigned long long)wall_clock64(); }
#undef PG8_STAMP
#undef PG8_SA
#undef PG8_SB
#undef PG8_STAGE
#undef PG8_LDA
#undef PG8_LDB
#undef PG8_MMA
#undef PG8_WAIT_V
#undef PG8_WAIT_L
#undef PG8_BAR
#undef PG8_SCHED
}
}
using pg8::bf16_t; using pg8::bf16x8; using pg8::f32x4; using pg8::u32x4;
#define LDSP __attribute__((address_space(3)))
typedef float f32x16 __attribute__((ext_vector_type(16)));
typedef float f32x2v __attribute__((ext_vector_type(2)));
typedef __bf16 bf16v2 __attribute__((ext_vector_type(2)));
typedef unsigned u32x2 __attribute__((ext_vector_type(2)));

constexpr int S = 16384, DM = 4096, DFF = 11008;
constexpr int ABW = 6912, NSW = 5728, NSWP = 5888;
constexpr float EPS = 1e-5f, SCALE = 0.08838834764831845f, LOG2E = 1.4426950408889634f, C2 = SCALE * LOG2E;
constexpr int NCMP = 1023, NCMPP = 1024;

constexpr size_t AL(size_t x) { return (x + 4095) & ~(size_t)4095; }
constexpr size_t OFF_BAR    = 0;
constexpr size_t OFF_DBG    = 16384;
constexpr size_t OFF_WT_ABIN  = 65536;
constexpr size_t OFF_WT_ABOUT = OFF_WT_ABIN  + AL((size_t)ABW * DM * 2);
constexpr size_t OFF_WT_GU0   = OFF_WT_ABOUT + AL((size_t)DM * DM * 2);
constexpr size_t OFF_WT_GU1   = OFF_WT_GU0   + AL((size_t)2 * DFF * DM * 2);
constexpr size_t OFF_WT_DN0   = OFF_WT_GU1   + AL((size_t)2 * DFF * DM * 2);
constexpr size_t OFF_WT_DN1   = OFF_WT_DN0   + AL((size_t)DM * DFF * 2);
constexpr size_t OFF_WT_NSIN  = OFF_WT_DN1   + AL((size_t)DM * DFF * 2);
constexpr size_t OFF_WT_NSOUT = OFF_WT_NSIN  + AL((size_t)NSWP * DM * 2);
constexpr size_t OFF_HB     = OFF_WT_NSOUT + AL((size_t)DM * DM * 2);
constexpr size_t OFF_OB     = OFF_HB   + AL((size_t)S * DM * 2);
constexpr size_t OFF_QKV    = OFF_OB   + AL((size_t)S * DM * 2);
constexpr size_t OFF_HID    = OFF_QKV  + AL((size_t)S * ABW * 2);
constexpr size_t OFF_X1     = OFF_HID  + AL((size_t)S * DFF * 2);
constexpr size_t OFF_X2     = OFF_X1   + AL((size_t)S * DM * 4);
constexpr size_t OFF_OACC   = OFF_X2   + AL((size_t)S * DM * 4);
constexpr size_t OFF_VTA    = OFF_OACC + AL((size_t)S * DM * 4);
constexpr size_t OFF_VTB    = OFF_VTA  + AL((size_t)1024 * S * 2);
constexpr size_t OFF_VTS    = OFF_VTB  + AL((size_t)384 * S * 2);
constexpr size_t OFF_VTW    = OFF_VTS  + AL((size_t)256 * S * 2);
constexpr size_t OFF_KCMP   = OFF_VTW  + AL((size_t)256 * S * 2);
constexpr size_t OFF_VCMPT  = OFF_KCMP + AL((size_t)2 * NCMPP * 128 * 2);
constexpr size_t OFF_IDX    = OFF_VCMPT + AL((size_t)2 * NCMPP * 128 * 2);
constexpr size_t OFF_SCR    = OFF_IDX  + AL((size_t)S * 2 * 8 * 4);
constexpr size_t WS_NEED    = OFF_SCR  + AL((size_t)64 << 20);

__device__ __forceinline__ unsigned pk2(float a, float b) { f32x2v v = {a, b}; return __builtin_bit_cast(unsigned, __builtin_convertvector(v, bf16v2)); }
__device__ __forceinline__ float bf2f(bf16_t x) { return __uint_as_float(((unsigned)x) << 16); }
__device__ __forceinline__ float ex2(float x) { return __builtin_amdgcn_exp2f(x); }
__device__ __forceinline__ float lg2(float x) { return __builtin_amdgcn_logf(x); }
__device__ __forceinline__ float sigmoidf_(float x) { return __builtin_amdgcn_rcpf(1.f + ex2(-x * LOG2E)); }
#define GAS __attribute__((address_space(1)))
template <class T> __device__ __forceinline__ T gld(const T* p) { return *(const GAS T*)p; }
template <class T> __device__ __forceinline__ T gldnt(const T* p) { return __builtin_nontemporal_load((const GAS T*)p); }
template <class T> __device__ __forceinline__ void gst(T* p, const T v) { *(GAS T*)p = v; }
template <class T> __device__ __forceinline__ void gstnt(T* p, const T v) { __builtin_nontemporal_store(v, (GAS T*)p); }
__device__ __forceinline__ float max3f(float a, float b, float c) { float d; asm("v_max3_f32 %0, %1, %2, %3" : "=v"(d) : "v"(a), "v"(b), "v"(c)); return d; }
#define MFMA32(a, b, c) __builtin_amdgcn_mfma_f32_32x32x16_bf16((a), (b), (c), 0, 0, 0)
#define MFMA16(a, b, c) __builtin_amdgcn_mfma_f32_16x16x32_bf16((a), (b), (c), 0, 0, 0)
struct EpiBf16 {
    static constexpr bool PERM = true, AFTER_DRAIN = false;
    bf16_t* O; bf16_t* vtA; bf16_t* vtB; unsigned* kpart; unsigned* kpartB; int ldc, va0, va1, vb0, vb1, k0, k1, k2, k3, pad_;
    __device__ __forceinline__ void operator()(const f32x4 (&acc)[2][2][4][2], const pg8::Unit& u, int wr, int wc, int fr, int fq) const {
        const int row0 = u.pm * 256 + wr * 64 + fr, col0 = u.pn * 256 + wc * 32 + 8 * fq;
#pragma unroll
        for (int bj = 0; bj < 2; ++bj) {
            const int colh = u.pn * 256 + bj * 128;
            bf16_t* vt = nullptr; int cb = 0;
            if (colh >= va0 && colh < va1) { vt = vtA; cb = colh - va0; } else if (colh >= vb0 && colh < vb1) { vt = vtB; cb = colh - vb0; }
            if (vt) {
                bf16_t* vp = vt + (size_t)(cb + wc * 32 + 8 * fq) * S + row0;
#pragma unroll
                for (int ai = 0; ai < 2; ++ai)
#pragma unroll
                    for (int m = 0; m < 4; ++m)
#pragma unroll
                        for (int n = 0; n < 2; ++n) { const f32x4 v = acc[ai][bj][m][n]; const unsigned w0 = pk2(v[0], v[1]), w1 = pk2(v[2], v[3]);
                            bf16_t* q = vp + (size_t)(4 * n) * S + ai * 128 + m * 16;
                            gst(q, (bf16_t)(w0 & 0xffffu)); gst(q + S, (bf16_t)(w0 >> 16)); gst(q + 2 * (size_t)S, (bf16_t)(w1 & 0xffffu)); gst(q + 3 * (size_t)S, (bf16_t)(w1 >> 16)); }
            } else {
                float kmx = 0.f; const bool knA = colh >= k0 && colh < k1, kn = knA || (colh >= k2 && colh < k3);
#pragma unroll
                for (int ai = 0; ai < 2; ++ai)
#pragma unroll
                    for (int m = 0; m < 4; ++m) { const f32x4 v0 = acc[ai][bj][m][0], v1 = acc[ai][bj][m][1];
                        u32x4 w; w.x = pk2(v0[0], v0[1]); w.y = pk2(v0[2], v0[3]); w.z = pk2(v1[0], v1[1]); w.w = pk2(v1[2], v1[3]);
                        gst((u32x4*)(O + (size_t)(row0 + ai * 128 + m * 16) * ldc + col0 + bj * 128), (u32x4)(w));
                        if (kn) { float ss = 0.f;
#pragma unroll
                            for (int e = 0; e < 4; ++e) { const float lo = __uint_as_float(w[e] << 16), hi = __uint_as_float(w[e] & 0xffff0000u); ss += lo * lo + hi * hi; }
                            ss += __shfl_xor(ss, 16); ss += __shfl_xor(ss, 32); kmx = fmaxf(kmx, ss); } }
                if (kn) {
#pragma unroll
                    for (int o_ = 8; o_ >= 1; o_ >>= 1) kmx = fmaxf(kmx, __shfl_xor(kmx, o_));
                    if ((fr | fq) == 0) atomicMax(knA ? kpart + ((colh - k0) >> 7) * 4 + wc : kpartB + ((colh - k2) >> 7) * 4 + wc, __float_as_uint(kmx)); }
            }
        }
    }
};
struct EpiRes {
    static constexpr bool PERM = true, AFTER_DRAIN = false;
    const bf16_t* base; bf16_t* out; int ldc, pad_;
    __device__ __forceinline__ void operator()(const f32x4 (&acc)[2][2][4][2], const pg8::Unit& u, int wr, int wc, int fr, int fq) const {
        const int row0 = u.pm * 256 + wr * 64 + fr, col0 = u.pn * 256 + wc * 32 + 8 * fq;
        u32x4 b[2][4][2];
#pragma unroll
        for (int ai = 0; ai < 2; ++ai)
#pragma unroll
            for (int m = 0; m < 4; ++m)
#pragma unroll
                for (int bj = 0; bj < 2; ++bj) b[ai][m][bj] = gldnt((const u32x4*)(base + (size_t)(row0 + ai * 128 + m * 16) * ldc + col0 + bj * 128));
        asm volatile("" ::: "memory");
#pragma unroll
        for (int ai = 0; ai < 2; ++ai)
#pragma unroll
            for (int m = 0; m < 4; ++m)
#pragma unroll
                for (int bj = 0; bj < 2; ++bj) { const f32x4 v0 = acc[ai][bj][m][0], v1 = acc[ai][bj][m][1]; const u32x4 r = b[ai][m][bj]; u32x4 w;
                    w.x = pk2(v0[0] + __uint_as_float(r.x << 16), v0[1] + __uint_as_float(r.x & 0xffff0000u)); w.y = pk2(v0[2] + __uint_as_float(r.y << 16), v0[3] + __uint_as_float(r.y & 0xffff0000u));
                    w.z = pk2(v1[0] + __uint_as_float(r.z << 16), v1[1] + __uint_as_float(r.z & 0xffff0000u)); w.w = pk2(v1[2] + __uint_as_float(r.w << 16), v1[3] + __uint_as_float(r.w & 0xffff0000u));
                    gst((u32x4*)(out + (size_t)(row0 + ai * 128 + m * 16) * ldc + col0 + bj * 128), (u32x4)(w)); }
    }
};
struct EpiSwiGLU {
    static constexpr bool PERM = true, AFTER_DRAIN = false;
    bf16_t* H; int ldh, tiled;
    __device__ __forceinline__ void operator()(const f32x4 (&acc)[2][2][4][2], const pg8::Unit& u, int wr, int wc, int fr, int fq) const {
        const int row0 = u.pm * 256 + wr * 64 + fr, col0 = u.pn * 128 + wc * 32 + 8 * fq;
#pragma unroll
        for (int ai = 0; ai < 2; ++ai)
#pragma unroll
            for (int m = 0; m < 4; ++m) { const int rr = wr * 64 + fr + ai * 128 + m * 16;
                bf16_t* rowp = tiled ? H + ((size_t)(u.pm * (ldh >> 6) + (col0 >> 6)) * 256 + rr) * 64 + (col0 & 63) : H + (size_t)(row0 + ai * 128 + m * 16) * ldh + col0;
                float hv[8];
#pragma unroll
                for (int n = 0; n < 2; ++n)
#pragma unroll
                    for (int e = 0; e < 4; ++e) { const float gt = acc[ai][0][m][n][e], up = acc[ai][1][m][n][e];
                        hv[n * 4 + e] = gt * __builtin_amdgcn_rcpf(1.f + ex2(-gt)) * up; }
                u32x4 w; w.x = pk2(hv[0], hv[1]); w.y = pk2(hv[2], hv[3]); w.z = pk2(hv[4], hv[5]); w.w = pk2(hv[6], hv[7]);
                gstnt((u32x4*)rowp, (u32x4)(w)); }
    }
};

struct CvtJob { const float* src; bf16_t* dst; int K, N, Nout, mode, tile0, ntn; };
constexpr int NCVT = 12;
struct CvtJobs { CvtJob j[NCVT]; int total; int pad_; };
__device__ __forceinline__ void cvt_phase(const CvtJobs& js, LDSP char* lds, int bid, int nb) {
    LDSP float* tb = (LDSP float*)lds;
    const int tid = tid_l();
    f32x4 v[4][2]; bf16_t* dp[4];
    auto issue = [&](int T0) {
#pragma unroll
        for (int q = 0; q < 4; ++q) {
            const int T = T0 + q * nb; dp[q] = nullptr;
#pragma unroll
            for (int i = 0; i < 2; ++i) v[q][i] = (f32x4){0.f, 0.f, 0.f, 0.f};
            if (T < js.total) {
                int ji = 0;
#pragma unroll
                for (int k = 1; k < NCVT; ++k) if (T >= js.j[k].tile0) ji = k;
                const CvtJob& J = js.j[ji]; const int lt = T - J.tile0, tn = lt % J.ntn, tk = lt / J.ntn, rho0 = tn * 64;
                int col0;
                float wsc = 1.f;
                if (J.mode & 1) { const int pn = rho0 >> 8, bj = (rho0 >> 7) & 1, cc = rho0 & 127; col0 = bj * DFF + pn * 128 + cc; wsc = bj ? (1.0f / LOG2E) : LOG2E; } else col0 = rho0;
#pragma unroll
                for (int i = 0; i < 2; ++i) { const int idx = tid + 512 * i, kr = idx >> 4, c4 = (idx & 15) * 4;
                    if (col0 + c4 < J.N) v[q][i] = gldnt((const f32x4*)(J.src + (size_t)(tk * 64 + kr) * J.N + col0 + c4)) * wsc; }
                { const int rho = rho0 + (tid >> 3);
                  dp[q] = (J.mode & 2) ? J.dst + ((size_t)((rho >> 8) * (J.K >> 6) + tk) * 256 + (rho & 255)) * 64 + (tid & 7) * 8 : J.dst + (size_t)rho * J.K + tk * 64 + (tid & 7) * 8; }
            }
        } };
    int T0 = bid;
    if (T0 < js.total) issue(T0);
    for (; T0 < js.total; T0 += 4 * nb) {
        bf16_t* dpc[4];
#pragma unroll
        for (int q = 0; q < 4; ++q) dpc[q] = dp[q];
#pragma unroll
        for (int q = 0; q < 4; ++q)
#pragma unroll
            for (int i = 0; i < 2; ++i) { const int idx = tid + 512 * i, kr = idx >> 4, c4 = (idx & 15) * 4; LDSP float* t = tb + q * (64 * 65) + kr * 65 + c4;
                t[0] = v[q][i][0]; t[1] = v[q][i][1]; t[2] = v[q][i][2]; t[3] = v[q][i][3]; }
        __syncthreads();
        if (T0 + 4 * nb < js.total) issue(T0 + 4 * nb);
#pragma unroll
        for (int q = 0; q < 4; ++q) if (dpc[q]) { const int nn = tid >> 3, k8 = (tid & 7) * 8; const LDSP float* t = tb + q * (64 * 65); float f[8];
#pragma unroll
            for (int e = 0; e < 8; ++e) f[e] = t[(k8 + e) * 65 + nn];
            u32x4 w; w.x = pk2(f[0], f[1]); w.y = pk2(f[2], f[3]); w.z = pk2(f[4], f[5]); w.w = pk2(f[6], f[7]);
            gstnt((u32x4*)dpc[q], (u32x4)(w)); }
        __syncthreads();
    }
}

template <bool F32OUT, bool BFIN, bool COPY>
__device__ __forceinline__ void rmsnorm_phase(const void* x, const float* g, bf16_t* hb, float* hf, bf16_t* xc, int bid, int nb) {
    const int wid = tid_l() >> 6, lane = tid_l() & 63;
    u32x4 rn[8];
    if (BFIN) { const int row = bid * 8 + wid;
        if (row < S) {
#pragma unroll
            for (int j = 0; j < 8; ++j) rn[j] = gld((const u32x4*)((const bf16_t*)x + (size_t)row * DM + (j * 64 + lane) * 8)); } }
    for (int row = bid * 8 + wid; row < S; row += nb * 8) {
        f32x4 v[8][2]; float ss = 0.f;
        if (BFIN) {
#pragma unroll
            for (int j = 0; j < 8; ++j) { const u32x4 r = rn[j];
                v[j][0] = (f32x4){__uint_as_float(r.x << 16), __uint_as_float(r.x & 0xffff0000u), __uint_as_float(r.y << 16), __uint_as_float(r.y & 0xffff0000u)};
                v[j][1] = (f32x4){__uint_as_float(r.z << 16), __uint_as_float(r.z & 0xffff0000u), __uint_as_float(r.w << 16), __uint_as_float(r.w & 0xffff0000u)}; }
            const int nrow = row + nb * 8;
            if (nrow < S) {
#pragma unroll
                for (int j = 0; j < 8; ++j) rn[j] = gld((const u32x4*)((const bf16_t*)x + (size_t)nrow * DM + (j * 64 + lane) * 8)); }
        } else { const float* xr = (const float*)x + (size_t)row * DM;
#pragma unroll
            for (int j = 0; j < 8; ++j) { v[j][0] = gldnt((const f32x4*)(xr + (j * 64 + lane) * 8)); v[j][1] = gldnt((const f32x4*)(xr + (j * 64 + lane) * 8 + 4)); } }
#pragma unroll
        for (int j = 0; j < 8; ++j)
#pragma unroll
            for (int q = 0; q < 2; ++q) ss += v[j][q][0] * v[j][q][0] + v[j][q][1] * v[j][q][1] + v[j][q][2] * v[j][q][2] + v[j][q][3] * v[j][q][3];
#pragma unroll
        for (int o = 32; o >= 1; o >>= 1) ss += __shfl_xor(ss, o);
        const float rstd = 1.0f / sqrtf(ss * (1.0f / DM) + EPS);
#pragma unroll
        for (int j = 0; j < 8; ++j) { const int c = (j * 64 + lane) * 8;
            if (COPY) { u32x4 w; w.x = pk2(v[j][0][0], v[j][0][1]); w.y = pk2(v[j][0][2], v[j][0][3]); w.z = pk2(v[j][1][0], v[j][1][1]); w.w = pk2(v[j][1][2], v[j][1][3]); gst((u32x4*)(xc + (size_t)row * DM + c), (u32x4)(w)); }
            const f32x4 y0 = v[j][0] * rstd * gld((const f32x4*)(g + c)), y1 = v[j][1] * rstd * gld((const f32x4*)(g + c + 4));
            if (F32OUT) { gstnt((f32x4*)(hf + (size_t)row * DM + c), (f32x4)(y0)); gstnt((f32x4*)(hf + (size_t)row * DM + c + 4), (f32x4)(y1)); }
            else { u32x4 w; w.x = pk2(y0[0], y0[1]); w.y = pk2(y0[2], y0[3]); w.z = pk2(y1[0], y1[1]); w.w = pk2(y1[2], y1[3]); gst((u32x4*)(hb + (size_t)row * DM + c), (u32x4)(w)); } }
    }
}
constexpr int KROW = 272, VROW = 144, KT_BYTES = 64 * KROW, VT_BYTES = 128 * VROW;
__device__ __forceinline__ int kperm_row(int kap) { const int i = kap & 15; return (kap & 32) + (i & 3) + 8 * (i >> 2) + 4 * ((kap >> 4) & 1); }

struct TileRegs { u32x4 k0, k1, v0, v1; };
constexpr int TB_BYTES = KT_BYTES + VT_BYTES;
__device__ __forceinline__ void g_load_k(TileRegs& R, const bf16_t* Kg, size_t ldk, int kbase, int tid) {
    const char* base = (const char*)(Kg + (size_t)kbase * ldk);
    const unsigned o0 = ((unsigned)(tid >> 4) * (unsigned)ldk + (unsigned)(tid & 15) * 8u) * 2u;
    R.k0 = gld((const u32x4*)(base + o0));
    R.k1 = gld((const u32x4*)(base + (o0 + 64u * (unsigned)ldk)));
}
__device__ __forceinline__ void g_load_v(TileRegs& R, const bf16_t* VTg, size_t ldv, int kbase, int tid) {
    const char* base = (const char*)(VTg + kbase);
    const unsigned o0 = ((unsigned)(tid >> 3) * (unsigned)ldv + (unsigned)(tid & 7) * 8u) * 2u;
    R.v0 = gld((const u32x4*)(base + o0));
    R.v1 = gld((const u32x4*)(base + (o0 + 128u * (unsigned)ldv)));
}
__device__ __forceinline__ void s_store_k(LDSP char* kl, const TileRegs& R, int tid) {
    const int row = tid >> 4, c16 = tid & 15;
    *(LDSP u32x4*)(kl + kperm_row(row) * KROW + c16 * 16) = R.k0;
    *(LDSP u32x4*)(kl + kperm_row(row + 32) * KROW + c16 * 16) = R.k1;
}
__device__ __forceinline__ void s_store_v(LDSP char* vl, const TileRegs& R, int tid) {
    const int row = tid >> 3, c16 = tid & 7;
    *(LDSP u32x4*)(vl + row * VROW + c16 * 16) = R.v0;
    *(LDSP u32x4*)(vl + (64 + row) * VROW + c16 * 16) = R.v1;
}
__device__ __forceinline__ void qk_tile(f32x16& p0, f32x16& p1, const LDSP char* kl, const bf16x8 (&qr)[8], int r, int h) {
#pragma unroll
    for (int i = 0; i < 16; ++i) { p0[i] = 0.f; p1[i] = 0.f; }
    const LDSP char* a = kl + r * KROW + h * 16;
    __builtin_amdgcn_s_setprio(1);
#pragma unroll
    for (int d0 = 0; d0 < 8; ++d0) {
        const bf16x8 a0 = *(const LDSP bf16x8*)(a + d0 * 32);
        const bf16x8 a1 = *(const LDSP bf16x8*)(a + 32 * KROW + d0 * 32);
        p0 = MFMA32(a0, qr[d0], p0); p1 = MFMA32(a1, qr[d0], p1);
        if (d0 & 1) asm volatile("" ::: "memory"); }
    __builtin_amdgcn_s_setprio(0);
}
__device__ __forceinline__ bf16x8 pack8(const f32x16& p, int s8) {
    u32x4 w; w.x = pk2(p[s8 + 0], p[s8 + 1]); w.y = pk2(p[s8 + 2], p[s8 + 3]); w.z = pk2(p[s8 + 4], p[s8 + 5]); w.w = pk2(p[s8 + 6], p[s8 + 7]);
    return __builtin_bit_cast(bf16x8, w);
}
__device__ __forceinline__ void pv_tile(f32x16 (&o)[4], const f32x16& p0, const f32x16& p1, const LDSP char* vl, int r, int h) {
    __builtin_amdgcn_s_setprio(1);
#pragma unroll
    for (int kb = 0; kb < 2; ++kb)
#pragma unroll
        for (int s = 0; s < 2; ++s) {
            const bf16x8 pb = kb ? pack8(p1, 8 * s) : pack8(p0, 8 * s);
#pragma unroll
            for (int d0 = 0; d0 < 4; ++d0) {
                const bf16x8 a = *(const LDSP bf16x8*)(vl + (32 * d0 + r) * VROW + (32 * kb + 16 * h + 8 * s) * 2);
                o[d0] = MFMA32(a, pb, o[d0]); }
            asm volatile("" ::: "memory"); }
    __builtin_amdgcn_s_setprio(0);
}
__device__ __forceinline__ void pv_tile_packed(f32x16 (&o)[4], const bf16x8 (&P)[4], const LDSP char* vl, int r, int h) {
    __builtin_amdgcn_s_setprio(1);
#pragma unroll
    for (int g = 0; g < 4; ++g) {
#pragma unroll
        for (int d0 = 0; d0 < 4; ++d0) {
            const bf16x8 a = *(const LDSP bf16x8*)(vl + (32 * d0 + r) * VROW + (32 * (g >> 1) + 16 * h + 8 * (g & 1)) * 2);
            o[d0] = MFMA32(a, P[g], o[d0]); }
        asm volatile("" ::: "memory"); }
    __builtin_amdgcn_s_setprio(0);
}
__device__ __forceinline__ void load_q(bf16x8 (&qr)[8], const bf16_t* qp  ) {
#pragma unroll
    for (int d0 = 0; d0 < 8; ++d0) qr[d0] = gld((const bf16x8*)(qp + 16 * d0));
}


template <int STRIDE, bool NEEDMAX = true>
__device__ __forceinline__ void tile_scores(f32x16& p0, f32x16& p1, float slope2, int tb, unsigned W, float& mx, float off = 0.f) {
    const float NINF = -__builtin_inff();
    const float cs = slope2 * (float)STRIDE, c0 = -slope2 * (float)tb - off, c1 = c0 + cs * 32.f;
#pragma unroll
    for (int i = 0; i < 16; ++i) { p0[i] = fmaf(p0[i], C2, fmaf(cs, (float)i, c0)); p1[i] = fmaf(p1[i], C2, fmaf(cs, (float)i, c1)); }
    if (!__all((tb - 47 * STRIDE >= 0) && ((unsigned)tb < W))) {
#pragma unroll
        for (int i = 0; i < 16; ++i) { p0[i] = ((unsigned)(tb - STRIDE * i) < W) ? p0[i] : NINF; p1[i] = ((unsigned)(tb - STRIDE * (32 + i)) < W) ? p1[i] : NINF; }
    }
    if (NEEDMAX) {
#pragma unroll
        for (int i = 0; i < 16; ++i) mx = max3f(mx, p0[i], p1[i]); }
}
constexpr float ZB_FAST = 60.f;
__device__ __forceinline__ void exp_acc(f32x16& p0, f32x16& p1, f32x2v& lacc) {
#pragma unroll
    for (int i = 0; i < 16; i += 2) {
        f32x2v a, b; a.x = ex2(p0[i]); a.y = ex2(p0[i + 1]); b.x = ex2(p1[i]); b.y = ex2(p1[i + 1]);
        p0[i] = a.x; p0[i + 1] = a.y; p1[i] = b.x; p1[i + 1] = b.y;
        lacc += a; lacc += b; }
}
__device__ __forceinline__ void softmax_upd(f32x16& p0, f32x16& p1, float mx, float& m, float& l, f32x16 (&o)[4]) {
    mx = fmaxf(mx, __shfl_xor(mx, 32));
    const float mn = fmaxf(m, mx), alpha = ex2(m - mn); m = mn;
    f32x2v acc = {0.f, 0.f};
#pragma unroll
    for (int i = 0; i < 16; i += 2) {
        f32x2v a = {p0[i], p0[i + 1]}, b = {p1[i], p1[i + 1]};
        a = a - mn; b = b - mn;
        a.x = ex2(a.x); a.y = ex2(a.y); b.x = ex2(b.x); b.y = ex2(b.y);
        p0[i] = a.x; p0[i + 1] = a.y; p1[i] = b.x; p1[i + 1] = b.y;
        acc += a; acc += b; }
    float ps = acc.x + acc.y; ps += __shfl_xor(ps, 32);
    l = l * alpha + ps;
    if (!__all(alpha == 1.f)) {
#pragma unroll
        for (int d0 = 0; d0 < 4; ++d0)
#pragma unroll
            for (int i = 0; i < 16; ++i) o[d0][i] *= alpha; }
}
__device__ __forceinline__ void softmax_pv(f32x16& p0, f32x16& p1, float mx, float& m, float& l, f32x16 (&o)[4], const LDSP char* vl, int r, int h) {
    softmax_upd(p0, p1, mx, m, l, o); pv_tile(o, p0, p1, vl, r, h);
}
constexpr int KBUF0 = 0, VBUF0 = 2 * KT_BYTES, AUX_OFF = 2 * KT_BYTES + 3 * VT_BYTES, NSA_SB_OFF = AUX_OFF + 2048;
template <class Seq, class Score>
__device__ __forceinline__ void attn_stream(const Seq& seq, const Score& score, const bf16_t* Kg, size_t ldk, const bf16_t* Vg, size_t ldv, const bf16x8 (&qr)[8],
                                            float& m, float& l, f32x16 (&o)[4], LDSP char* lds, int tid, int r, int h, bool grpB, bool fast) {
    TileRegs R; int kb = 0, vb = 0, vprev = 0; bool pend = false; bf16x8 P[4]; f32x2v lacc = {0.f, 0.f};
    int t = seq.first();
    g_load_k(R, Kg, ldk, seq.base(t), tid); g_load_v(R, Vg, ldv, seq.base(t), tid);
    s_store_k(lds + KBUF0, R, tid); s_store_v(lds + VBUF0, R, tid);
    __syncthreads();
    while (t >= 0) {
        const LDSP char* kl = lds + KBUF0 + kb * KT_BYTES; const LDSP char* vl = lds + VBUF0 + vb * VT_BYTES;
        const int tn = seq.next(t);
        if (tn >= 0) { g_load_k(R, Kg, ldk, seq.base(tn), tid); g_load_v(R, Vg, ldv, seq.base(tn), tid); }
        if (grpB && pend) { pv_tile_packed(o, P, lds + VBUF0 + vprev * VT_BYTES, r, h); pend = false; }
        f32x16 p0, p1; qk_tile(p0, p1, kl, qr, r, h);
        float mx = -__builtin_inff();
        if (score(p0, p1, t, mx)) {
            if (fast) exp_acc(p0, p1, lacc); else softmax_upd(p0, p1, mx, m, l, o);
            P[0] = pack8(p0, 0); P[1] = pack8(p0, 8); P[2] = pack8(p1, 0); P[3] = pack8(p1, 8);
            if (grpB) { pend = true; vprev = vb; } else pv_tile_packed(o, P, vl, r, h);
        }
        const int vn = vb == 2 ? 0 : vb + 1;
        if (tn >= 0) { s_store_k(lds + KBUF0 + (kb ^ 1) * KT_BYTES, R, tid); s_store_v(lds + VBUF0 + vn * VT_BYTES, R, tid); }
        __syncthreads(); kb ^= 1; vb = vn; t = tn;
    }
    if (grpB && pend) pv_tile_packed(o, P, lds + VBUF0 + vprev * VT_BYTES, r, h);
    if (fast) { float ps = lacc.x + lacc.y; ps += __shfl_xor(ps, 32); l += ps; }
    __syncthreads();
}
__device__ __forceinline__ float sb_block_prod(f32x16& p, int kpos0, int t, float cP, int h, bool interior) {
    if (!interior) {
#pragma unroll
        for (int i = 0; i < 16; ++i) p[i] = ((kpos0 + i) < t) ? p[i] : -__builtin_inff(); }
    float run = 1.f;
#pragma unroll
    for (int i = 15; i >= 0; --i) {
        const float e = fminf(ex2(p[i] * C2), 1.8446744e19f), nb = __builtin_amdgcn_rcpf(1.f + e);
        run *= nb; p[i] = e * run; }
    const float T = run, PT = __shfl_xor(T, 32);
    const float sc = cP * (h == 0 ? PT : 1.f);
#pragma unroll
    for (int i = 0; i < 16; ++i) p[i] *= sc;
    return T * PT;
}
__device__ __forceinline__ void sb_unit(const bf16_t* qkv, const bf16_t* vta, bf16_t* ob, const float* kmax2, int head, int qb, LDSP char* lds) {
    const int tid = tid_l(), wid = __builtin_amdgcn_readfirstlane(tid >> 6), lane = tid & 63, r = lane & 31, h = lane >> 5;
    const int t0 = qb * 256, tq0 = t0 + 32 * wid, t = tq0 + r;
    LDSP int* votes = (LDSP int*)(lds + 2 * TB_BYTES);
    bf16x8 qr[8]; load_q(qr, qkv + (size_t)t * ABW + head * 128 + 8 * h);
    float qn2 = 0.f;
#pragma unroll
    for (int d0 = 0; d0 < 8; ++d0)
#pragma unroll
        for (int e = 0; e < 8; ++e) { const float v = bf2f((bf16_t)qr[d0][e]); qn2 += v * v; }
    qn2 += __shfl_xor(qn2, 32);
    const float km2 = (gld(kmax2 + 4 * head) + gld(kmax2 + 4 * head + 1)) + (gld(kmax2 + 4 * head + 2) + gld(kmax2 + 4 * head + 3));
    const float zb = sqrtf(qn2 * km2) * C2 * 1.001f + 1.0f;
    const bf16_t* Kg = qkv + 1024 + head * 128;
    const bf16_t* Vg = vta + (size_t)head * 128 * S;
    f32x16 o[4];
#pragma unroll
    for (int d0 = 0; d0 < 4; ++d0)
#pragma unroll
        for (int i = 0; i < 16; ++i) o[d0][i] = 0.f;
    float carry = 0.f;
    if (lane < 2) votes[lane * 8 + wid] = 0;
    const int jhi = (t0 + 254) >> 6;
    TileRegs R; int buf = 0, done = 0;
    g_load_k(R, Kg, ABW, jhi * 64, tid); g_load_v(R, Vg, S, jhi * 64, tid);
    s_store_k(lds, R, tid); s_store_v(lds + KT_BYTES, R, tid);
    __syncthreads();
    for (int j = jhi; j >= 0; --j) {
        const LDSP char* kl = lds + buf * TB_BYTES; const LDSP char* vl = kl + KT_BYTES;
        if (j > 0) { g_load_k(R, Kg, ABW, (j - 1) * 64, tid); g_load_v(R, Vg, S, (j - 1) * 64, tid); }
        if (!done && j * 64 < tq0 + 31) {
            f32x16 p0, p1; qk_tile(p0, p1, kl, qr, r, h);
            const float cP = ex2(carry); float b1, b0;
            const bool interior = j * 64 + 63 < tq0;
            b1 = sb_block_prod(p1, j * 64 + 32 + 16 * h, t, cP, h, interior); b0 = sb_block_prod(p0, j * 64 + 16 * h, t, cP * b1, h, interior);
            carry += lg2(b1 * b0);
            pv_tile(o, p0, p1, vl, r, h);
            done = __all(carry + zb < -140.f) ? 1 : 0;
        }
        if (lane == 0) votes[(j & 1) * 8 + wid] = done;
        if (j > 0) { s_store_k(lds + (buf ^ 1) * TB_BYTES, R, tid); s_store_v(lds + (buf ^ 1) * TB_BYTES + KT_BYTES, R, tid); }
        __syncthreads();
        { int all = 1;
#pragma unroll
          for (int w = 0; w < 8; ++w) all &= votes[(j & 1) * 8 + w];
          if (all) break; }
        buf ^= 1;
    }
    __syncthreads();
    bf16_t* op = ob + (size_t)t * DM + head * 128 + 4 * h;
#pragma unroll
    for (int d0 = 0; d0 < 4; ++d0)
#pragma unroll
        for (int g = 0; g < 4; ++g) { u32x2 w; w.x = pk2(o[d0][4 * g], o[d0][4 * g + 1]); w.y = pk2(o[d0][4 * g + 2], o[d0][4 * g + 3]); gst((u32x2*)(op + 32 * d0 + 8 * g), (u32x2)(w)); }
}
template <int W, bool SINK, bool NSAWIN>
__device__ __forceinline__ void win_unit(const bf16_t* qkv, int ld, int qcol, int kcol, const bf16_t* vt, float slope, float sinkv, float gate,
                                         const float* oacc, const float* oslc, bf16_t* ob, int ocol, int qt, LDSP char* lds) {
    const int tid = tid_l(), lane = tid & 63, r = lane & 31, h = lane >> 5;
    const int t0 = qt * 32, t = t0 + r;
    bf16x8 qr[8]; load_q(qr, qkv + (size_t)t * ld + qcol + 8 * h);
    const float slope2 = slope * LOG2E;
    float m = SINK ? sinkv * LOG2E : -1e30f, l = SINK ? 1.f : 0.f;
    f32x16 o[4];
#pragma unroll
    for (int d0 = 0; d0 < 4; ++d0)
#pragma unroll
        for (int i = 0; i < 16; ++i) o[d0][i] = 0.f;
    int lowk = t0 - (W - 1); if (lowk < 0) lowk = 0;
    const int jlo = lowk >> 6, jhi = (t0 + 31) >> 6;
    struct Seq { int lo, hi; __device__ int first() const { return hi; } __device__ int next(int t_) const { return t_ > lo ? t_ - 1 : -1; } __device__ int base(int t_) const { return t_ * 64; } } seq{jlo, jhi};
    auto score = [&](f32x16& p0, f32x16& p1, int tl, float& mx) { tile_scores<1>(p0, p1, slope2, t - tl * 64 - 16 * h, (unsigned)W, mx); return true; };
    attn_stream(seq, score, qkv + kcol, (size_t)ld, vt, (size_t)S, qr, m, l, o, lds, tid, r, h, (tid >> 8) != 0, false);
    const float inv = (NSAWIN ? gate : 1.f) / l;
    bf16_t* op = ob + (size_t)t * DM + ocol + 4 * h;
    const float* ap = oacc + (size_t)t * DM + ocol + 4 * h;
    const float* sp = oslc + (size_t)t * DM + ocol + 4 * h;
#pragma unroll
    for (int d0 = 0; d0 < 4; ++d0)
#pragma unroll
        for (int g = 0; g < 4; ++g) {
            f32x4 v = {o[d0][4 * g] * inv, o[d0][4 * g + 1] * inv, o[d0][4 * g + 2] * inv, o[d0][4 * g + 3] * inv};
            if (NSAWIN) v += gld((const f32x4*)(ap + 32 * d0 + 8 * g)) + gld((const f32x4*)(sp + 32 * d0 + 8 * g));
            u32x2 w; w.x = pk2(v[0], v[1]); w.y = pk2(v[2], v[3]); gst((u32x2*)(op + 32 * d0 + 8 * g), (u32x2)(w)); }
}
__device__ __forceinline__ float slope_l0(int kvh, int g) { return exp2f(-8.f * (float)(3 * g + kvh + 1) / 24.f); }
__device__ __forceinline__ float slope_l1(int kvh, int g) { return exp2f(-8.f * (float)(2 * g + kvh + 1) / 32.f); }

#define LADD(p, v) ((void)__hip_atomic_fetch_add((p), (v), __ATOMIC_RELAXED, __HIP_MEMORY_SCOPE_WORKGROUP))
__device__ __forceinline__ float gelu_tanh(float x) { const float u = 0.7978845608028654f * (x + 0.044715f * x * x * x); const float e = ex2(-2.f * LOG2E * fabsf(u)); const float th = (1.f - e) / (1.f + e); return 0.5f * x * (1.f + (u < 0.f ? -th : th)); }

__device__ __forceinline__ int prev_bit(const LDSP unsigned* bm, int from) {
    if (from < 0) return -1;
    int w = from >> 5; unsigned word = bm[w] & (0xffffffffu >> (31 - (from & 31)));
    while (!word && --w >= 0) word = bm[w];
    return word ? w * 32 + (31 - __builtin_clz(word)) : -1;
}

__device__ __forceinline__ void nsa_unit(const bf16_t* qkv, const bf16_t* kcmp, const bf16_t* vcmpt, const bf16_t* vts, const bf16_t* vtw, const float* kb, bf16_t* ob, int kvh, int qt, LDSP char* lds) {
    const int tid = tid_l(), wid = __builtin_amdgcn_readfirstlane(tid >> 6), lane = tid & 63, r = lane & 31, h = lane >> 5;
    const int t0 = qt * 32, t = t0 + r;
    LDSP int* idl = (LDSP int*)(lds + AUX_OFF);
    LDSP unsigned* bm = (LDSP unsigned*)(idl + 256);
    LDSP int* jsl = (LDSP int*)(bm + 8);
    LDSP unsigned* imp = (LDSP unsigned*)(lds + NSA_SB_OFF);
    LDSP u32x4* slcb = (LDSP u32x4*)(lds + NSA_SB_OFF) + wid * 512 + lane;
    const float kcm2 = ((gld(kb + 16 + kvh * 8 + 0) + gld(kb + 16 + kvh * 8 + 1)) + (gld(kb + 16 + kvh * 8 + 2) + gld(kb + 16 + kvh * 8 + 3))) + ((gld(kb + 16 + kvh * 8 + 4) + gld(kb + 16 + kvh * 8 + 5)) + (gld(kb + 16 + kvh * 8 + 6) + gld(kb + 16 + kvh * 8 + 7)));
    const float ksm2 = (gld(kb + kvh * 4 + 0) + gld(kb + kvh * 4 + 1)) + (gld(kb + kvh * 4 + 2) + gld(kb + kvh * 4 + 3));
    const float kwm2 = (gld(kb + 8 + kvh * 4 + 0) + gld(kb + 8 + kvh * 4 + 1)) + (gld(kb + 8 + kvh * 4 + 2) + gld(kb + 8 + kvh * 4 + 3));
    for (int i = tid; i < 32 * 257; i += 512) imp[i] = 0u;
    if (tid < 8) bm[tid] = 0u;
    const float NINF = -__builtin_inff();
    {
    const int ntiles = ((t0 >> 4) >> 6) + 1;
    const bf16_t* Kg = kcmp + (size_t)kvh * NCMPP * 128;
    const bf16_t* Vg = vcmpt + (size_t)kvh * 128 * NCMPP;
    for (int hh = 0; hh < 2; ++hh) {
        const int g = 8 * hh + wid, hq = kvh * 16 + g;
        const float slope2 = slope_l1(kvh, g) * LOG2E;
        bf16x8 qr[8]; load_q(qr, qkv + (size_t)t * NSWP + hq * 128 + 8 * h);
        float m = -1e30f, l = 0.f;
        float qn2 = 0.f;
#pragma unroll
        for (int d0 = 0; d0 < 8; ++d0)
#pragma unroll
            for (int e = 0; e < 8; ++e) { const float v = bf2f((bf16_t)qr[d0][e]); qn2 += v * v; }
        qn2 += __shfl_xor(qn2, 32);
        float zbw = sqrtf(qn2 * kcm2) * C2 * 1.001f + 0.5f;
#pragma unroll
        for (int o_ = 16; o_ >= 1; o_ >>= 1) zbw = fmaxf(zbw, __shfl_xor(zbw, o_));
        int js;
        { const float X = (float)(t0 - 1039) - (152.f + 2.f * zbw + 15.f * slope2) / slope2; js = X > 0.f ? (int)floorf(X * (1.0f / 1024.0f)) : 0; if (js > ntiles - 1) js = ntiles - 1; }
        js = __builtin_amdgcn_readfirstlane(js);
        const bool fast = zbw <= ZB_FAST;
        f32x2v lacc = {0.f, 0.f};
        if (lane == 0) jsl[wid] = js;
        TileRegs R; int buf = 0;
        __syncthreads();
        int jmin = jsl[0];
#pragma unroll
        for (int w = 1; w < 8; ++w) jmin = min(jmin, jsl[w]);
        g_load_k(R, Kg, 128, jmin * 64, tid); s_store_k(lds, R, tid);
        __syncthreads();
        for (int j = jmin; j < ntiles; ++j) {
            const LDSP char* kl = lds + buf * TB_BYTES;
            if (j + 1 < ntiles) g_load_k(R, Kg, 128, (j + 1) * 64, tid);
            if (j >= js) {
            f32x16 p0, p1; qk_tile(p0, p1, kl, qr, r, h);
            float mx = NINF;
            if (fast) { tile_scores<16, false>(p0, p1, slope2, t - 16 * (j * 64 + 16 * h) - 31, 0x7fffffffu, mx); exp_acc(p0, p1, lacc); } else {
            tile_scores<16>(p0, p1, slope2, t - 16 * (j * 64 + 16 * h) - 31, 0x7fffffffu, mx);
            mx = fmaxf(mx, __shfl_xor(mx, 32));
            const float mn = fmaxf(m, mx); f32x2v acc = {0.f, 0.f};
#pragma unroll
            for (int i = 0; i < 16; i += 2) { f32x2v a = {p0[i], p0[i + 1]}, b = {p1[i], p1[i + 1]}; a = a - mn; b = b - mn;
                a.x = ex2(a.x); a.y = ex2(a.y); b.x = ex2(b.x); b.y = ex2(b.y); acc += a; acc += b; }
            float ps = acc.x + acc.y; ps += __shfl_xor(ps, 32);
            l = l * ex2(m - mn) + ps; m = mn; }
            }
            if (j + 1 < ntiles) s_store_k(lds + (buf ^ 1) * TB_BYTES, R, tid);
            __syncthreads(); buf ^= 1;
        }
        if (fast) { float ps = lacc.x + lacc.y; ps += __shfl_xor(ps, 32); l = ps; m = 0.f; }
        const float linv = 1.f / fmaxf(l, 1e-30f);
        f32x16 o[4];
#pragma unroll
        for (int d0 = 0; d0 < 4; ++d0)
#pragma unroll
            for (int i = 0; i < 16; ++i) o[d0][i] = 0.f;
        buf = 0;
        g_load_k(R, Kg, 128, jmin * 64, tid); g_load_v(R, Vg, NCMPP, jmin * 64, tid); s_store_k(lds, R, tid); s_store_v(lds + KT_BYTES, R, tid);
        __syncthreads();
        for (int j = jmin; j < ntiles; ++j) {
            const LDSP char* kl = lds + buf * TB_BYTES; const LDSP char* vl = kl + KT_BYTES;
            if (j + 1 < ntiles) { g_load_k(R, Kg, 128, (j + 1) * 64, tid); g_load_v(R, Vg, NCMPP, (j + 1) * 64, tid); }
            if (j >= js) {
            f32x16 p0, p1; qk_tile(p0, p1, kl, qr, r, h);
            float mx = 0.f; tile_scores<16, false>(p0, p1, slope2, t - 16 * (j * 64 + 16 * h) - 31, 0x7fffffffu, mx, m);
#pragma unroll
            for (int i = 0; i < 16; i += 2) { f32x2v a = {p0[i], p0[i + 1]}, b = {p1[i], p1[i + 1]};
                a.x = ex2(a.x); a.y = ex2(a.y); b.x = ex2(b.x); b.y = ex2(b.y); a = a * linv; b = b * linv;
                p0[i] = a.x; p0[i + 1] = a.y; p1[i] = b.x; p1[i + 1] = b.y; }
            LDSP unsigned* ir = imp + r * 257 + 16 * j + 4 * h;
#pragma unroll
            for (int q4 = 0; q4 < 4; ++q4) {
                const float s0 = (p0[4 * q4] + p0[4 * q4 + 1]) + (p0[4 * q4 + 2] + p0[4 * q4 + 3]);
                const float s1 = (p1[4 * q4] + p1[4 * q4 + 1]) + (p1[4 * q4 + 2] + p1[4 * q4 + 3]);
                LADD(ir + q4, (unsigned)(s0 * 16777216.f + 0.5f));
                LADD(ir + q4 + 1, (unsigned)(p0[4 * q4 + 3] * 16777216.f + 0.5f));
                LADD(ir + 8 + q4, (unsigned)(s1 * 16777216.f + 0.5f));
                LADD(ir + 8 + q4 + 1, (unsigned)(p1[4 * q4 + 3] * 16777216.f + 0.5f)); }
            pv_tile(o, p0, p1, vl, r, h);
            }
            if (j + 1 < ntiles) { s_store_k(lds + (buf ^ 1) * TB_BYTES, R, tid); s_store_v(lds + (buf ^ 1) * TB_BYTES + KT_BYTES, R, tid); }
            __syncthreads(); buf ^= 1;
        }
        const float gate = sigmoidf_(bf2f(gld(qkv + ((size_t)t * NSWP + 5632 + kvh * 48 + g * 3 + 0))));
        bf16_t* op = ob + (size_t)t * DM + hq * 128 + 4 * h;
#pragma unroll
        for (int d0 = 0; d0 < 4; ++d0)
#pragma unroll
            for (int gq = 0; gq < 4; ++gq) { u32x2 w; w.x = pk2(o[d0][4 * gq] * gate, o[d0][4 * gq + 1] * gate); w.y = pk2(o[d0][4 * gq + 2] * gate, o[d0][4 * gq + 3] * gate);
                gst((u32x2*)(op + 32 * d0 + 8 * gq), (u32x2)(w)); }
    }
    }
    __syncthreads();
    {
        const int qq = lane >> 4, sub = lane & 15, rq = wid * 4 + qq, cur = (t0 + rq) >> 6;
        int sc[16];
#pragma unroll
        for (int e = 0; e < 16; ++e) { const int j = sub + 16 * e; const bool valid = j <= cur, forced = (j == 0) || (j == cur) || (j == cur - 1);
            sc[e] = valid ? (int)(imp[rq * 257 + j] + (forced ? (1u << 30) : 0u) + 1u) : 0; }
        for (int rd = 0; rd < 8; ++rd) {
            int bs = sc[0], bj = sub;
#pragma unroll
            for (int e = 1; e < 16; ++e) { const bool tk = sc[e] > bs; bs = tk ? sc[e] : bs; bj = tk ? sub + 16 * e : bj; }
#pragma unroll
            for (int o_ = 1; o_ <= 8; o_ <<= 1) { const int os = __shfl_xor(bs, o_), oj = __shfl_xor(bj, o_); const bool tk = (os > bs) || (os == bs && oj < bj); bs = tk ? os : bs; bj = tk ? oj : bj; }
            if (sub == 0) idl[rq * 8 + rd] = bj;
#pragma unroll
            for (int e = 0; e < 16; ++e) sc[e] = (bj == sub + 16 * e) ? -1 : sc[e];
        }
    }
    __syncthreads();
    if (tid < 256) { const int b = idl[tid]; if (b * 64 <= t0 + 31) (void)__hip_atomic_fetch_or(bm + (b >> 5), 1u << (b & 31), __ATOMIC_RELAXED, __HIP_MEMORY_SCOPE_WORKGROUP); }
    unsigned s_lo = 0u, s_hi = 0u;
#pragma unroll
    for (int e = 0; e < 4; ++e) { s_lo |= (unsigned)idl[r * 8 + e] << (8 * e); s_hi |= (unsigned)idl[r * 8 + 4 + e] << (8 * e); }
    __syncthreads();
    for (int hh = 0; hh < 2; ++hh) {
        const int g = 8 * hh + wid, hq = kvh * 16 + g;
        const float slope2 = slope_l1(kvh, g) * LOG2E;
        bf16x8 qr[8]; load_q(qr, qkv + (size_t)t * NSWP + hq * 128 + 8 * h);
        float qn = 0.f;
#pragma unroll
        for (int d0 = 0; d0 < 8; ++d0)
#pragma unroll
            for (int e = 0; e < 8; ++e) { const float v = bf2f((bf16_t)qr[d0][e]); qn += v * v; }
        qn += __shfl_xor(qn, 32);
#pragma unroll
        for (int o_ = 16; o_ >= 1; o_ >>= 1) qn = fmaxf(qn, __shfl_xor(qn, o_));
        const float zbs = sqrtf(qn * ksm2) * C2 * 1.001f + 0.5f, zbw_ = sqrtf(qn * kwm2) * C2 * 1.001f + 0.5f;
        const float zs2 = 2.f * zbs + 152.f, zw2 = 2.f * zbw_ + 152.f;
        const bool fasts = zbs <= ZB_FAST, fastw = zbw_ <= ZB_FAST;
        {
            const bf16_t* Kg = qkv + 4608 + kvh * 128; const bf16_t* Vg = vts + (size_t)kvh * 128 * S;
            float m = -1e30f, l = 0.f; f32x16 o[4];
#pragma unroll
            for (int d0 = 0; d0 < 4; ++d0)
#pragma unroll
                for (int i = 0; i < 16; ++i) o[d0][i] = 0.f;
            struct Seq { const LDSP unsigned* bm; __device__ int first() const { return prev_bit(bm, 255); } __device__ int next(int t_) const { return prev_bit(bm, t_ - 1); } __device__ int base(int t_) const { return t_ * 64; } } seq{bm};
            auto score = [&](f32x16& p0, f32x16& p1, int b, float& mx) {
                const unsigned bb = (unsigned)b * 0x01010101u, x0 = s_lo ^ bb, x1 = s_hi ^ bb;
                const bool selq = (((x0 - 0x01010101u) & ~x0 & 0x80808080u) | ((x1 - 0x01010101u) & ~x1 & 0x80808080u)) != 0u;
                if (!__any(selq)) return false;
                if (slope2 * (float)(t0 - b * 64 - 63) > zs2) return false;
                if (fasts) tile_scores<1, false>(p0, p1, slope2, t - b * 64 - 16 * h, selq ? 0x7fffffffu : 0u, mx);
                else tile_scores<1>(p0, p1, slope2, t - b * 64 - 16 * h, selq ? 0x7fffffffu : 0u, mx);
                return true; };
            attn_stream(seq, score, Kg, (size_t)NSWP, Vg, (size_t)S, qr, m, l, o, lds, tid, r, h, wid >= 4, fasts);
            const float f = sigmoidf_(bf2f(gld(qkv + ((size_t)t * NSWP + 5632 + kvh * 48 + g * 3 + 1)))) / l;
#pragma unroll
            for (int d0 = 0; d0 < 4; ++d0)
#pragma unroll
                for (int g2 = 0; g2 < 2; ++g2) { u32x4 w;
                    w.x = pk2(o[d0][8 * g2] * f, o[d0][8 * g2 + 1] * f); w.y = pk2(o[d0][8 * g2 + 2] * f, o[d0][8 * g2 + 3] * f);
                    w.z = pk2(o[d0][8 * g2 + 4] * f, o[d0][8 * g2 + 5] * f); w.w = pk2(o[d0][8 * g2 + 6] * f, o[d0][8 * g2 + 7] * f);
                    slcb[(d0 * 2 + g2) * 64] = w; }
        }
        {
            const bf16_t* Kg = qkv + 5120 + kvh * 128; const bf16_t* Vg = vtw + (size_t)kvh * 128 * S;
            float m = -1e30f, l = 0.f; f32x16 o[4];
#pragma unroll
            for (int d0 = 0; d0 < 4; ++d0)
#pragma unroll
                for (int i = 0; i < 16; ++i) o[d0][i] = 0.f;
            int lowk = t0 - 511; if (lowk < 0) lowk = 0;
            const int jlo = lowk >> 6, jhi = (t0 + 31) >> 6;
            struct Seq { int lo, hi; __device__ int first() const { return hi; } __device__ int next(int t_) const { return t_ > lo ? t_ - 1 : -1; } __device__ int base(int t_) const { return t_ * 64; } } seq{jlo, jhi};
            auto score = [&](f32x16& p0, f32x16& p1, int j, float& mx) {
                if (slope2 * (float)(t0 - j * 64 - 63) > zw2) return false;
                if (fastw) tile_scores<1, false>(p0, p1, slope2, t - j * 64 - 16 * h, 512u, mx);
                else tile_scores<1>(p0, p1, slope2, t - j * 64 - 16 * h, 512u, mx);
                return true; };
            attn_stream(seq, score, Kg, (size_t)NSWP, Vg, (size_t)S, qr, m, l, o, lds, tid, r, h, wid >= 4, fastw);
            const float f = sigmoidf_(bf2f(gld(qkv + ((size_t)t * NSWP + 5632 + kvh * 48 + g * 3 + 2)))) / l;
            bf16_t* op = ob + (size_t)t * DM + hq * 128 + 4 * h;
#pragma unroll
            for (int d0 = 0; d0 < 4; ++d0)
#pragma unroll
                for (int g2 = 0; g2 < 2; ++g2) { const u32x4 b = slcb[(d0 * 2 + g2) * 64];
#pragma unroll
                    for (int q2 = 0; q2 < 2; ++q2) { const int gq = 2 * g2 + q2; const u32x2 a = gld((const u32x2*)(op + 32 * d0 + 8 * gq)); const unsigned b0 = b[2 * q2], b1 = b[2 * q2 + 1];
                        u32x2 w; w.x = pk2((__uint_as_float(a.x << 16) + __uint_as_float(b0 << 16)) + o[d0][4 * gq] * f, (__uint_as_float(a.x & 0xffff0000u) + __uint_as_float(b0 & 0xffff0000u)) + o[d0][4 * gq + 1] * f);
                        w.y = pk2((__uint_as_float(a.y << 16) + __uint_as_float(b1 << 16)) + o[d0][4 * gq + 2] * f, (__uint_as_float(a.y & 0xffff0000u) + __uint_as_float(b1 & 0xffff0000u)) + o[d0][4 * gq + 3] * f);
                        gst((u32x2*)(op + 32 * d0 + 8 * gq), (u32x2)(w)); } }
        }
    }
    __syncthreads();
}

__device__ __forceinline__ void posb_compute(const float* pos, const float* w1, float* posb, int jg, LDSP char* lds) {
    LDSP float* red = (LDSP float*)lds;
    const int tid = tid_l(), jj = tid & 7, sp = tid >> 3; float a = 0.f;
#pragma unroll 8
    for (int k = sp * 64; k < sp * 64 + 64; ++k) a += gld(pos + k) * gld(w1 + (size_t)k * 128 + 8 * jg + jj);
    red[sp * 8 + jj] = a; __syncthreads();
    if (tid < 8) { float s = 0.f; for (int q = 0; q < 64; ++q) s += red[q * 8 + tid]; gst(posb + 8 * jg + tid, s); }
    __syncthreads();
}
__device__ __forceinline__ void cmp_mlp_unit2(const bf16_t* qkv, const bf16_t* w1t, const bf16_t* w2t, const float* posb, bf16_t* kcmp, bf16_t* vcmpt, unsigned* kpc, int which, int kvh, int grp, LDSP char* lds) {
    LDSP bf16_t* gl = (LDSP bf16_t*)(lds + 81920);
    const int tid = tid_l(), wid = __builtin_amdgcn_readfirstlane(tid >> 6), lane = tid & 63, nl = lane & 15, quad = lane >> 4;
    const int c0 = grp * 16, scol = (which ? 4352 : 4096) + kvh * 128;
    for (int q = tid; q < 272 * 16; q += 512) { const int R = q >> 4, ch = q & 15; int gr = 16 * c0 + R; gr = gr < S ? gr : S - 1;
        *(LDSP u32x4*)(lds + ((R & 15) * 17 + (R >> 4)) * 272 + ch * 16) = gld((const u32x4*)(qkv + (size_t)gr * NSWP + scol + ch * 8)); }
    __syncthreads();
    const bf16_t* bp = w1t + (size_t)(16 * wid + nl) * 4096 + 8 * quad;
    f32x4 acc = {0.f, 0.f, 0.f, 0.f};
    for (int ks0 = 0; ks0 < 128; ks0 += 16) {
        bf16x8 b[16];
#pragma unroll
        for (int u = 0; u < 16; ++u) b[u] = gld((const bf16x8*)(bp + 32 * (ks0 + u)));
#pragma unroll
        for (int u = 0; u < 16; ++u) { const int ks = ks0 + u, ro = ks >> 2;
            const bf16x8 a = *(const LDSP bf16x8*)(lds + ((ro & 15) * 17 + nl + (ro >> 4)) * 272 + ((ks & 3) * 32 + 8 * quad) * 2);
            acc = MFMA16(a, b[u], acc); }
    }
    { const float pb = gld(posb + 16 * wid + nl);
#pragma unroll
      for (int i = 0; i < 4; ++i) gl[(4 * quad + i) * 136 + 16 * wid + nl] = (bf16_t)(pk2(gelu_tanh(acc[i] + pb), 0.f) & 0xffffu); }
    __syncthreads();
    f32x4 acc2 = {0.f, 0.f, 0.f, 0.f};
#pragma unroll
    for (int js = 0; js < 4; ++js) { const bf16x8 a = *(const LDSP bf16x8*)(gl + nl * 136 + 32 * js + 8 * quad);
        const bf16x8 b = gld((const bf16x8*)(w2t + (size_t)(16 * wid + nl) * 128 + 32 * js + 8 * quad));
        acc2 = MFMA16(a, b, acc2); }
    const int n2 = 16 * wid + nl;
#pragma unroll
    for (int i = 0; i < 4; ++i) if (c0 + 4 * quad + i >= NCMP) acc2[i] = 0.f;
    if (which == 0) {
        float kmx = 0.f;
#pragma unroll
        for (int i = 0; i < 4; ++i) { const unsigned w = pk2(acc2[i], 0.f) & 0xffffu; gst(kcmp + ((size_t)kvh * NCMPP + c0 + 4 * quad + i) * 128 + n2, (bf16_t)w);
            float ss = __uint_as_float(w << 16); ss *= ss;
#pragma unroll
            for (int o_ = 1; o_ <= 8; o_ <<= 1) ss += __shfl_xor(ss, o_);
            kmx = fmaxf(kmx, ss); }
        kmx = fmaxf(kmx, __shfl_xor(kmx, 16)); kmx = fmaxf(kmx, __shfl_xor(kmx, 32));
        if (lane == 0) atomicMax(kpc + kvh * 8 + wid, __float_as_uint(kmx));
    } else { u32x2 w; w.x = pk2(acc2[0], acc2[1]); w.y = pk2(acc2[2], acc2[3]); gst((u32x2*)(vcmpt + ((size_t)kvh * 128 + n2) * NCMPP + c0 + 4 * quad), (u32x2)(w)); }
    __syncthreads();
}
struct Ptrs {
    const float *x, *attn_norm, *ffn_norm, *w_gate_up, *w_down, *ab_w_in, *ab_sinks, *ab_w_out, *nsa_w_in, *cmp_pos, *wk1, *wk2, *wv1, *wv2, *nsa_w_out, *final_norm;
    float* out; char* ws;
};
#define WSP(T, off) ((T*)(p.ws + (off)))
constexpr size_t OFF_W1TK = OFF_SCR, OFF_W1TV = OFF_W1TK + 128 * 4096 * 2, OFF_W2TK = OFF_W1TV + 128 * 4096 * 2, OFF_W2TV = OFF_W2TK + 128 * 128 * 2, OFF_POSB = OFF_W2TV + 128 * 128 * 2;
constexpr size_t OFF_KMAX = 14336;
constexpr size_t OFF_OSLC = OFF_HID;
__device__ __forceinline__ void attn_l0_phase(const Ptrs& p, LDSP char* lds, int bid, int nb) {
    const bf16_t* qkv = WSP(const bf16_t, OFF_QKV); bf16_t* ob = WSP(bf16_t, OFF_OB);
    const int wid = __builtin_amdgcn_readfirstlane(tid_l() >> 6);
    for (int u = bid; u < 512 + 1536; u += nb) {
        if (u < 512) { const int head = u & 7, qb = 63 - (u >> 3); sb_unit(qkv, WSP(const bf16_t, OFF_VTA), ob, WSP(const float, OFF_KMAX), head, qb, lds); }
        else { const int v = u - 512, kvh = v % 3, qt = v / 3; const int hq = kvh * 8 + wid;
            win_unit<128, true, false>(qkv, ABW, 3072 + hq * 128, 6144 + kvh * 128, WSP(const bf16_t, OFF_VTB) + (size_t)kvh * 128 * S, slope_l0(kvh, wid), gld(p.ab_sinks + hq), 1.f,
                                       (const float*)nullptr, (const float*)nullptr, ob, 1024 + hq * 128, qt, lds); }
    }
}
__device__ __forceinline__ void cmp_mlp_phase(const Ptrs& p, LDSP char* lds, int bid, int nb) {
    for (int u = bid; u < 256; u += nb) { const int which = u & 1, kvh = (u >> 1) & 1, grp = u >> 2;
        cmp_mlp_unit2(WSP(const bf16_t, OFF_QKV), which ? WSP(const bf16_t, OFF_W1TV) : WSP(const bf16_t, OFF_W1TK), which ? WSP(const bf16_t, OFF_W2TV) : WSP(const bf16_t, OFF_W2TK),
                      WSP(const float, OFF_POSB) + which * 128, WSP(bf16_t, OFF_KCMP), WSP(bf16_t, OFF_VCMPT), WSP(unsigned, OFF_KMAX) + 48, which, kvh, grp, lds); }
}
__device__ __forceinline__ void nsa_phase(const Ptrs& p, LDSP char* lds, int bid, int nb) {
    const int lb = (nb == 256) ? ((bid & 7) * 32 + (bid >> 3)) : bid;
    for (int u = lb; u < 1024; u += nb) { const int kvh = u & 1, b_ = (u & 255) >> 1, i_ = u >> 8; const int qt = i_ == 0 ? 511 - b_ : i_ == 1 ? 256 + b_ : i_ == 2 ? 255 - b_ : b_;
        nsa_unit(WSP(const bf16_t, OFF_QKV), WSP(const bf16_t, OFF_KCMP), WSP(const bf16_t, OFF_VCMPT), WSP(const bf16_t, OFF_VTS), WSP(const bf16_t, OFF_VTW), WSP(const float, OFF_KMAX) + 32, WSP(bf16_t, OFF_OB), kvh, qt, lds); }
}
template <class Epi> __device__ __forceinline__ void gemm_call(LDSP char* lds, const bf16_t* A, const bf16_t* Bt, int M, int N, int K, int tiled, const Epi& E, int bid, int nb) {
    pg8::Gemm g{A, Bt, M, N, K, tiled}; pg8::StaticOrder So; So.init(M, N, nb, bid);
    pg8::gemm_phase<Epi, pg8::StaticOrder, false>((PG8_LAS unsigned char*)lds, g, So, E, nullptr);
}

constexpr int LDS_GEMM = pg8::STAGE_BYTES;
constexpr int LDS_ST = NSA_SB_OFF + 65536;
constexpr int LDS_TOTAL = LDS_ST + 16;
static_assert(XCD_BAR_WORDS * 4 <= OFF_KMAX && NSA_SB_OFF + 32 * 257 * 4 <= LDS_GEMM && LDS_GEMM <= LDS_ST && LDS_TOTAL <= 163840 && (144 * 128 + 4 * 9 * 128 + 8 * 128) * 4 <= LDS_GEMM, "LDS");
extern __shared__ __attribute__((aligned(16))) unsigned char dyn_lds[];
#ifndef DUP_MASK
#define DUP_MASK 0
#endif
#define REP(k, ...) do { _Pragma("nounroll") for (int rep_ = 0; rep_ < 1 + ((DUP_MASK >> (k)) & 1); ++rep_) { __VA_ARGS__; } } while (0)
#ifndef PROBE_BLK
#define PROBE_BLK 0
#endif
#ifndef PROBE_T
#define PROBE_T 0
#endif
#define TIMEIT(bit, ...) do { if (PROBE_T & (bit)) { const unsigned long long t0_ = wall_clock64(); __VA_ARGS__; tacc += wall_clock64() - t0_; } else { __VA_ARGS__; } } while (0)
#define GBAR() TIMEIT(1, xcd_barrier(bar))
struct MkArgs { Ptrs p; CvtJobs js; unsigned* bar; };
__global__ __launch_bounds__(512, 2) void k_mega(MkArgs a) {
    LDSP char* lds = (LDSP char*)dyn_lds;
    volatile LAS unsigned* st = (volatile LAS unsigned*)(lds + LDS_ST);
    if (threadIdx.x < 4) st[threadIdx.x] = 0u;
    __syncthreads();
    XcdBarrier bar = xcd_barrier_post(a.bar, st);
    unsigned long long tacc = 0ull;
    if (blockIdx.x >= 64 && blockIdx.x < 96) { const int wh = blockIdx.x & 1, jg = (blockIdx.x - 64) >> 1; posb_compute(a.p.cmp_pos, wh ? a.p.wv1 : a.p.wk1, (float*)(a.p.ws + OFF_POSB) + wh * 128, jg, lds); }
    TIMEIT(2, REP(0, cvt_phase(a.js, lds, (int)blockIdx.x, (int)gridDim.x)));
#pragma nounroll
    for (int layer = 0; layer < 2; ++layer) {
        int bid = (int)blockIdx.x, nb = (int)gridDim.x; Ptrs p = a.p;
        asm volatile("" : "+s"(bid), "+s"(nb), "+s"(p.ws));
        bf16_t *hb = WSP(bf16_t, OFF_HB), *ob = WSP(bf16_t, OFF_OB), *qkv = WSP(bf16_t, OFF_QKV), *hid = WSP(bf16_t, OFF_HID);
        bf16_t *x1 = WSP(bf16_t, OFF_X1), *x2 = WSP(bf16_t, OFF_X2);
        if (layer == 0) { TIMEIT(16, REP(1, rmsnorm_phase<false, false, true>(p.x, p.attn_norm, hb, (float*)nullptr, x2, bid, nb))); }
        else { TIMEIT(16, REP(1, rmsnorm_phase<false, true, false>(x2, p.attn_norm + DM, hb, (float*)nullptr, (bf16_t*)nullptr, bid, nb))); }
        GBAR();
        {
            const EpiBf16 E0{qkv, WSP(bf16_t, OFF_VTA), WSP(bf16_t, OFF_VTB), WSP(unsigned, OFF_KMAX), (unsigned*)nullptr, ABW, 2048, 3072, 6528, 6912, 1024, 2048, 0, 0, 0};
            const EpiBf16 E1{qkv, WSP(bf16_t, OFF_VTS), WSP(bf16_t, OFF_VTW), WSP(unsigned, OFF_KMAX) + 32, WSP(unsigned, OFF_KMAX) + 40, NSWP, 4864, 5120, 5376, 5632, 4608, 4864, 5120, 5376, 0};
            TIMEIT(4 | 32, gemm_call(lds, hb, layer ? WSP(const bf16_t, OFF_WT_NSIN) : WSP(const bf16_t, OFF_WT_ABIN), S, layer ? NSWP : ABW, DM, 0, layer ? E1 : E0, bid, nb)); }
        GBAR();
        if (layer == 0) {
            TIMEIT(8, REP(2, attn_l0_phase(p, lds, bid, nb)));
        } else {
            TIMEIT(16 | 512, REP(3, cmp_mlp_phase(p, lds, bid, nb)));
            GBAR();
            TIMEIT(8, REP(4, nsa_phase(p, lds, bid, nb)));
        }
        GBAR();
        TIMEIT(4 | 64, REP(9, gemm_call(lds, ob, layer ? WSP(const bf16_t, OFF_WT_NSOUT) : WSP(const bf16_t, OFF_WT_ABOUT), S, DM, DM, 0, EpiRes{x2, x1, DM, 0}, bid, nb)));
        GBAR();
        TIMEIT(16, REP(1, rmsnorm_phase<false, true, false>(x1, p.ffn_norm + layer * DM, hb, (float*)nullptr, (bf16_t*)nullptr, bid, nb)));
        GBAR();
        TIMEIT(4 | 128, REP(10, gemm_call(lds, hb, layer ? WSP(const bf16_t, OFF_WT_GU1) : WSP(const bf16_t, OFF_WT_GU0), S, 2 * DFF, DM, 0, EpiSwiGLU{hid, DFF, 1}, bid, nb)));
        GBAR();
        TIMEIT(4 | 256, REP(11, gemm_call(lds, hid, layer ? WSP(const bf16_t, OFF_WT_DN1) : WSP(const bf16_t, OFF_WT_DN0), S, DM, DFF, 3, EpiRes{x1, x2, DM, 0}, bid, nb)));
        GBAR();
    }
    { const Ptrs& p = a.p;
      rmsnorm_phase<true, true, false>(WSP(const bf16_t, OFF_X2), p.final_norm, (bf16_t*)nullptr, p.out, (bf16_t*)nullptr, (int)blockIdx.x, (int)gridDim.x); }
    if (PROBE_T && blockIdx.x == PROBE_BLK) { const unsigned long long t0_ = wall_clock64(); while (wall_clock64() - t0_ < tacc) __builtin_amdgcn_s_sleep(8); }
}
extern "C" void kernel_launch(void* const* d_in, const int* in_sizes, int n_in, void* d_out, int out_size, void* d_ws, size_t ws_size, hipStream_t stream) {
    (void)in_sizes; (void)out_size;
    if (n_in != 16 || ws_size < WS_NEED) { fprintf(stderr, "kernel_launch: bad arguments (n_in %d, ws %zu, need %zu)\n", n_in, ws_size, (size_t)WS_NEED); return; }
    static int grid = 0;
    if (!grid) { int dev = 0, cus = 0, per_cu = 0; (void)hipGetDevice(&dev);
        if (hipDeviceGetAttribute(&cus, hipDeviceAttributeMultiprocessorCount, dev) != hipSuccess || cus <= 0) cus = 256;
        hipError_t e = hipFuncSetAttribute((const void*)k_mega, hipFuncAttributeMaxDynamicSharedMemorySize, LDS_TOTAL);
        if (e != hipSuccess) fprintf(stderr, "hipFuncSetAttribute: %s\n", hipGetErrorString(e));
        if (hipOccupancyMaxActiveBlocksPerMultiprocessor(&per_cu, (const void*)k_mega, 512, LDS_TOTAL) != hipSuccess || per_cu < 1) { fprintf(stderr, "occupancy query failed (%d)\n", per_cu); per_cu = 1; }
        grid = cus * 1; }
    MkArgs a{};
    Ptrs& p = a.p;
    p.x = (const float*)d_in[0]; p.attn_norm = (const float*)d_in[1]; p.ffn_norm = (const float*)d_in[2]; p.w_gate_up = (const float*)d_in[3]; p.w_down = (const float*)d_in[4];
    p.ab_w_in = (const float*)d_in[5]; p.ab_sinks = (const float*)d_in[6]; p.ab_w_out = (const float*)d_in[7]; p.nsa_w_in = (const float*)d_in[8]; p.cmp_pos = (const float*)d_in[9];
    p.wk1 = (const float*)d_in[10]; p.wk2 = (const float*)d_in[11]; p.wv1 = (const float*)d_in[12]; p.wv2 = (const float*)d_in[13]; p.nsa_w_out = (const float*)d_in[14]; p.final_norm = (const float*)d_in[15];
    p.out = (float*)d_out; p.ws = (char*)d_ws;
    { const float* srcs[NCVT] = {p.ab_w_in, p.ab_w_out, p.w_gate_up, p.w_gate_up + (size_t)DM * 2 * DFF, p.w_down, p.w_down + (size_t)DFF * DM, p.nsa_w_in, p.nsa_w_out, p.wk1, p.wv1, p.wk2, p.wv2};
      const size_t offs[NCVT] = {OFF_WT_ABIN, OFF_WT_ABOUT, OFF_WT_GU0, OFF_WT_GU1, OFF_WT_DN0, OFF_WT_DN1, OFF_WT_NSIN, OFF_WT_NSOUT, OFF_W1TK, OFF_W1TV, OFF_W2TK, OFF_W2TV};
      const int Ks[NCVT] = {DM, DM, DM, DM, DFF, DFF, DM, DM, 4096, 4096, 128, 128}, Ns[NCVT] = {ABW, DM, 2 * DFF, 2 * DFF, DM, DM, NSW, DM, 128, 128, 128, 128}, No[NCVT] = {ABW, DM, 2 * DFF, 2 * DFF, DM, DM, NSWP, DM, 128, 128, 128, 128}, md[NCVT] = {0, 0, 1, 1, 2, 2, 0, 0, 0, 0, 0, 0};
      int t0 = 0; for (int i = 0; i < NCVT; ++i) { a.js.j[i] = CvtJob{srcs[i], (bf16_t*)(p.ws + offs[i]), Ks[i], Ns[i], No[i], md[i], t0, No[i] / 64}; t0 += (No[i] / 64) * (Ks[i] / 64); } a.js.total = t0; }
    a.bar = (unsigned*)(p.ws + OFF_BAR);
    (void)hipMemsetAsync(a.bar, 0, 16384, stream);
    hipLaunchKernelGGL(k_mega, dim3(grid), dim3(512), LDS_TOTAL, stream, a);
}
```

```cpp
#include <hip/hip_runtime.h>
#include <stdint.h>
#include <stdio.h>
__device__ __forceinline__ int tid_l() { int t = (int)threadIdx.x; asm volatile("" : "+v"(t)); return t; }
#define XB_TMO      128
#define XB_XCNT(j)  (256  + 64 * (j))
#define XB_XSUB(j)  (1280 + 64 * (j))
#define XB_XGEN(j)  (2304 + 64 * (j))
#define XB_TOP      3328
#define XB_TOPGEN   3392
#define XCD_BAR_WORDS 3456
#define XB_SPIN_CAP (1u << 18)
#define LAS __attribute__((address_space(3)))

__device__ __forceinline__ unsigned xb_ld(unsigned* p)              { return __hip_atomic_load(p, __ATOMIC_RELAXED, __HIP_MEMORY_SCOPE_AGENT); }
__device__ __forceinline__ unsigned xb_add(unsigned* p, unsigned v) { return __hip_atomic_fetch_add(p, v, __ATOMIC_RELAXED, __HIP_MEMORY_SCOPE_AGENT); }
__device__ __forceinline__ unsigned xb_xcc_id() { return (unsigned)__builtin_amdgcn_s_getreg((3 << 11) | 20) & 0xFu; }
#define XB_SPIN(cond, bar) do { unsigned _sp = 0; while (cond) { __builtin_amdgcn_s_sleep(1); \
    if ((++_sp & 255u) == 0u) { if (xb_ld(&(bar)[XB_TMO])) break; if (_sp > XB_SPIN_CAP) { atomicAdd(&(bar)[XB_TMO], 1u); break; } } } } while (0)

struct XcdBarrier {
    unsigned* bar; unsigned x;
    volatile LAS unsigned* st;
};

__device__ __forceinline__ XcdBarrier xcd_barrier_post(unsigned* bar, volatile LAS unsigned* st) {
    XcdBarrier b; b.bar = bar; b.x = xb_xcc_id(); b.st = st;
    if (threadIdx.x == 0) (void)xb_add(&bar[XB_XCNT(b.x)], 1u);
    return b;
}
__device__ __forceinline__ void xcd_barrier_complete(unsigned* bar, unsigned x, unsigned& nloc, unsigned& nx) {
    const unsigned G = gridDim.x * gridDim.y * gridDim.z;
    unsigned sum, cnt, mine, sp = 0u;
    for (;;) {
        sum = 0u; cnt = 0u; mine = 0u;
#pragma unroll
        for (unsigned j = 0; j < 16; ++j) { const unsigned c = xb_ld(&bar[XB_XCNT(j)]); sum += c; cnt += (c > 0u) ? 1u : 0u; mine = (j == x) ? c : mine; }
        if (sum == G) break;
        __builtin_amdgcn_s_sleep(1);
        if ((++sp & 255u) == 0u) { if (xb_ld(&bar[XB_TMO])) break; if (sp > XB_SPIN_CAP) { atomicAdd(&bar[XB_TMO], 1u); break; } }
    }
    nloc = mine > 0u ? mine : 1u; nx = cnt > 0u ? cnt : 1u;
}

__device__ __forceinline__ void xcd_barrier(const XcdBarrier& b) {
    asm volatile("s_waitcnt vmcnt(0)" ::: "memory");
    __syncthreads();
    if (threadIdx.x == 0) {
        unsigned* bar = b.bar;
        __builtin_amdgcn_s_waitcnt(0);
        unsigned nloc = b.st[0], nx = b.st[1];
        if (nloc == 0u) { xcd_barrier_complete(bar, b.x, nloc, nx); b.st[0] = nloc; b.st[1] = nx; }
        const unsigned old = xb_add(&bar[XB_XSUB(b.x)], 1u);
        const unsigned gen = old / nloc;
        if (old + 1u == (gen + 1u) * nloc) {
            __builtin_amdgcn_fence(__ATOMIC_RELEASE, "agent");
            asm volatile("s_waitcnt vmcnt(0)" ::: "memory");
            const unsigned og = xb_add(&bar[XB_TOP], 1u);
            const unsigned tg = og / nx;
            if (og + 1u == (tg + 1u) * nx) xb_add(&bar[XB_TOPGEN], 1u);
            else XB_SPIN(xb_ld(&bar[XB_TOPGEN]) == tg, bar);
            __builtin_amdgcn_fence(__ATOMIC_ACQUIRE, "agent");
            xb_add(&bar[XB_XGEN(b.x)], 1u);
            asm volatile("s_waitcnt vmcnt(0)" ::: "memory");
        } else {
            XB_SPIN(xb_ld(&bar[XB_XGEN(b.x)]) == gen, bar);
            __builtin_amdgcn_fence(__ATOMIC_ACQUIRE, "agent");
            asm volatile("s_waitcnt vmcnt(0)" ::: "memory");
        }
    }
    __syncthreads();
}

namespace pg8 {
#define PG8_LAS __attribute__((address_space(3)))
typedef unsigned short bf16_t;
typedef short bf16x8 __attribute__((ext_vector_type(8)));
typedef float f32x4 __attribute__((ext_vector_type(4)));
typedef unsigned u32x4 __attribute__((ext_vector_type(4)));
constexpr int BM = 256, BK = 64, HALF = 128, HTB = HALF * BK * 2  , STAGE_BYTES = 8 * HTB, NXCD = 8, WGM = 8;

__host__ __device__ __forceinline__ int lds_byte(int r, int c) { const int st = (r >> 4) * 2 + (c >> 5), rr = r & 15, cc = c & 31, ob = rr * 64 + cc * 2; return st * 1024 + (ob ^ (((ob >> 9) & 1) << 5)); }
__host__ __device__ __forceinline__ void stage_rc(int b, int& R, int& C) { const int st = b / 1024, sb = b % 1024, swz = sb ^ (((sb >> 9) & 1) << 5); R = (st >> 1) * 16 + swz / 64; C = (st & 1) * 32 + (swz % 64) / 2; }
__host__ __device__ __forceinline__ int perm32(int rho) { const int n = rho >> 4, i = rho & 15; return 8 * (i >> 2) + 4 * n + (i & 3); }

struct Unit { int pm, pn; };
struct Gemm { const bf16_t* A; const bf16_t* Bt; int M, N, K, tiled; };

struct StaticOrder {
    int nM, nN, nwg, G, c;
    __host__ __device__ void init(int M, int N, int G_, int c_) { nM = M / BM; nN = N / BM; nwg = nM * nN; G = G_; c = c_; }
    __host__ __device__ bool next(int i, Unit& u) const {
        const long L = (long)i * G + c; if (L >= nwg) return false;
        int wgid = (int)L; { const int q = nwg / NXCD, r = nwg % NXCD, xcd = wgid % NXCD, off = wgid / NXCD; wgid = (xcd < r ? xcd * (q + 1) : r * (q + 1) + (xcd - r) * q) + off; }
        const int nig = WGM * nN, gid = wgid / nig, fm = gid * WGM, gsz = (nM - fm) < WGM ? (nM - fm) : WGM;
        u.pm = fm + ((wgid % nig) % gsz); u.pn = (wgid % nig) / gsz; return true;
    }
    __device__ __forceinline__ void a_ready(const Unit&) const {}
    __device__ __forceinline__ void done(const Unit&) const {}
};
__device__ __forceinline__ unsigned cvt_pk_bf16(float lo, float hi) { unsigned r; asm volatile("v_cvt_pk_bf16_f32 %0, %1, %2" : "=v"(r) : "v"(lo), "v"(hi)); return r; }
typedef float f32x2 __attribute__((ext_vector_type(2)));
template <class Epi, class Sched, bool STAMP = false>
__device__ __forceinline__ void gemm_phase(PG8_LAS unsigned char* lds, const Gemm g, const Sched& S, const Epi& E, unsigned long long* stamps) {
    const int tid = tid_l(), wid = __builtin_amdgcn_readfirstlane(tid >> 6), lane = tid & 63, wr = wid >> 2, wc = wid & 3, fr = lane & 15, fq = lane >> 4;
    const int K = g.K, nt = K / BK;
    int ts_lo = 0, ts_hi = 0, nts = 0; const unsigned long long rt_entry = STAMP ? (unsigned long long)wall_clock64() : 0ull;
#define PG8_STAMP() do { if (STAMP && wid == 0 && nts < 64) { const unsigned long long _c = (unsigned long long)clock64(); \
        ts_lo = (lane == nts) ? (int)(unsigned)_c : ts_lo; ts_hi = (lane == nts) ? (int)(unsigned)(_c >> 32) : ts_hi; ++nts; } } while (0)
    PG8_STAMP();
    unsigned voffA[2], voffB[2];
#pragma unroll
    for (int i = 0; i < 2; ++i) { int R, C; stage_rc(tid * 16 + i * 8192, R, C); const int Rb = Epi::PERM ? ((R & ~31) + perm32(R & 31)) : R;
        voffA[i] = (unsigned)(R * ((g.tiled & 1) ? 64 : K) + C) * 2u; voffB[i] = (unsigned)(Rb * ((g.tiled & 2) ? 64 : K) + C) * 2u; }
    const size_t tstep = (size_t)BM * K * 2;
    const size_t akstep = (g.tiled & 1) ? (size_t)BM * BK * 2 : (size_t)(BK * 2), bkstep = (g.tiled & 2) ? (size_t)BM * BK * 2 : (size_t)(BK * 2);
    const size_t ahstep = (g.tiled & 1) ? (size_t)HALF * BK * 2 : (size_t)HALF * K * 2, bhstep = (g.tiled & 2) ? (size_t)HALF * BK * 2 : (size_t)HALF * K * 2;
    const unsigned ldsw = (unsigned)wid * 1024u;
    const int aoff = lds_byte(wr * 64 + fr, fq * 8), boff = lds_byte(wc * 32 + fr, fq * 8);
#define PG8_SA(b, h) (((b) * 2 + (h)) * HTB)
#define PG8_SB(b, h) ((4 + (b) * 2 + (h)) * HTB)
#define PG8_STAGE(bufoff, gbase, voff) do { _Pragma("unroll") for (int _i = 0; _i < 2; ++_i) \
        __builtin_amdgcn_global_load_lds((const unsigned*)((const char*)(gbase) + (voff)[_i]), (PG8_LAS unsigned*)(lds + (bufoff) + ldsw + _i * 8192), 16, 0, 0); } while (0)
#define PG8_LDA(dst, b, h) do { _Pragma("unroll") for (int m = 0; m < 4; ++m) _Pragma("unroll") for (int k = 0; k < 2; ++k) dst[m][k] = *(const PG8_LAS bf16x8*)(lds + PG8_SA(b, h) + aoff + m * 2048 + k * 1024); } while (0)
#define PG8_LDB(dst, b, h) do { _Pragma("unroll") for (int n = 0; n < 2; ++n) _Pragma("unroll") for (int k = 0; k < 2; ++k) dst[n][k] = *(const PG8_LAS bf16x8*)(lds + PG8_SB(b, h) + boff + n * 2048 + k * 1024); } while (0)
#define PG8_MMA(ai, bj, At, Bt) do { __builtin_amdgcn_s_setprio(1); _Pragma("unroll") for (int m = 0; m < 4; ++m) _Pragma("unroll") for (int n = 0; n < 2; ++n) _Pragma("unroll") for (int k = 0; k < 2; ++k) \
        acc[ai][bj][m][n] = __builtin_amdgcn_mfma_f32_16x16x32_bf16(Bt[n][k], At[m][k], acc[ai][bj][m][n], 0, 0, 0); __builtin_amdgcn_s_setprio(0); } while (0)
#define PG8_WAIT_V(n) asm volatile("s_waitcnt vmcnt(" #n ")" ::: "memory")
#define PG8_WAIT_L(n) asm volatile("s_waitcnt lgkmcnt(" #n ")" ::: "memory")
#define PG8_BAR __builtin_amdgcn_s_barrier()
#define PG8_SCHED __builtin_amdgcn_sched_barrier(0)
    Unit cur, nxt; int ui = 0;
    if (!S.next(0, cur)) return;
    f32x4 acc[2][2][4][2];
#pragma unroll
    for (int a = 0; a < 2; ++a)
#pragma unroll
        for (int b = 0; b < 2; ++b)
#pragma unroll
            for (int m = 0; m < 4; ++m)
#pragma unroll
                for (int n = 0; n < 2; ++n) acc[a][b][m][n] = (f32x4){0.f, 0.f, 0.f, 0.f};
    bf16x8 At[4][2], B0[2][2], B1[2][2];
    const char* cA = (const char*)g.A + (size_t)cur.pm * tstep; const char* cB = (const char*)g.Bt + (size_t)cur.pn * tstep;
    S.a_ready(cur);
    PG8_STAGE(PG8_SB(0, 0), cB, voffB); PG8_STAGE(PG8_SA(0, 0), cA, voffA); PG8_STAGE(PG8_SB(0, 1), cB + bhstep, voffB); PG8_STAGE(PG8_SA(0, 1), cA + ahstep, voffA);
    if (wr == 1) PG8_BAR;
    PG8_WAIT_V(4); PG8_BAR;
    PG8_STAGE(PG8_SB(1, 0), cB + bkstep, voffB); PG8_STAGE(PG8_SA(1, 0), cA + akstep, voffA); PG8_STAGE(PG8_SB(1, 1), cB + bhstep + bkstep, voffB);
    PG8_WAIT_V(6); PG8_BAR;
    PG8_STAMP();
    for (;;) {
        const bool has_next = S.next(ui + 1, nxt);
        const char* nA = has_next ? (const char*)g.A + (size_t)nxt.pm * tstep : cA; const char* nB = has_next ? (const char*)g.Bt + (size_t)nxt.pn * tstep : cB;
        for (int t = 0; t < nt; t += 2) {
            const bool last = (t == nt - 2);
            const char* a1 = cA + (size_t)(t + 1) * akstep;
            const char* a2 = last ? nA : cA + (size_t)(t + 2) * akstep; const char* b2 = last ? nB : cB + (size_t)(t + 2) * bkstep;
            const char* a3 = a2 + akstep; const char* b3 = b2 + bkstep;
            if (last && has_next) S.a_ready(nxt);
            PG8_LDB(B0, 0, 0); PG8_SCHED; PG8_LDA(At, 0, 0); PG8_STAGE(PG8_SA(1, 1), a1 + ahstep, voffA);
            PG8_WAIT_L(8); PG8_BAR; PG8_WAIT_L(0); PG8_MMA(0, 0, At, B0); PG8_BAR; PG8_SCHED;
            PG8_LDB(B1, 0, 1); PG8_STAGE(PG8_SB(0, 0), b2, voffB);
            PG8_BAR; PG8_WAIT_L(0); PG8_MMA(0, 1, At, B1); PG8_BAR;
            PG8_LDA(At, 0, 1); PG8_STAGE(PG8_SA(0, 0), a2, voffA);
            PG8_BAR; PG8_WAIT_L(0); PG8_MMA(1, 0, At, B0); PG8_BAR; PG8_SCHED;
            PG8_STAGE(PG8_SB(0, 1), b2 + bhstep, voffB);
            PG8_WAIT_V(6); PG8_BAR; PG8_MMA(1, 1, At, B1); PG8_BAR;
            PG8_LDB(B0, 1, 0); PG8_SCHED; PG8_LDA(At, 1, 0); PG8_STAGE(PG8_SA(0, 1), a2 + ahstep, voffA);
            PG8_WAIT_L(8); PG8_BAR; PG8_WAIT_L(0); PG8_MMA(0, 0, At, B0); PG8_BAR; PG8_SCHED;
            PG8_LDB(B1, 1, 1); PG8_STAGE(PG8_SB(1, 0), b3, voffB);
            PG8_BAR; PG8_WAIT_L(0); PG8_MMA(0, 1, At, B1); PG8_BAR;
            PG8_LDA(At, 1, 1); PG8_STAGE(PG8_SA(1, 0), a3, voffA);
            PG8_BAR; PG8_WAIT_L(0); PG8_MMA(1, 0, At, B0); PG8_BAR; PG8_SCHED;
            PG8_STAGE(PG8_SB(1, 1), b3 + bhstep, voffB);
            PG8_WAIT_V(6); PG8_BAR; PG8_MMA(1, 1, At, B1); PG8_BAR;
        }
        PG8_STAMP();
        if constexpr (!Epi::AFTER_DRAIN) { E(acc, cur, wr, wc, fr, fq); S.done(cur); }
        PG8_STAMP();
        if (!has_next) break;
#pragma unroll
        for (int a = 0; a < 2; ++a)
#pragma unroll
            for (int b = 0; b < 2; ++b)
#pragma unroll
                for (int m = 0; m < 4; ++m)
#pragma unroll
                    for (int n = 0; n < 2; ++n) acc[a][b][m][n] = (f32x4){0.f, 0.f, 0.f, 0.f};
        cur = nxt; cA = nA; cB = nB; ++ui;
    }
    PG8_WAIT_V(0);
    if (wr == 0) PG8_BAR;
    PG8_BAR;
    if constexpr (Epi::AFTER_DRAIN) { E.fused(acc, cur, wr, wc, fr, fq, lds, wid, lane); S.done(cur); }
    PG8_STAMP();
    if (STAMP && wid == 0) { stamps[lane] = lane < nts ? (((unsigned long long)(unsigned)ts_hi << 32) | (unsigned)ts_lo) : 0ull;
        if (lane == 62) stamps[62] = rt_entry; if (lane == 63) stamps[63] = (unsigned long long)wall_clock64(); }
#undef PG8_STAMP
#undef PG8_SA
#undef PG8_SB
#undef PG8_STAGE
#undef PG8_LDA
#undef PG8_LDB
#undef PG8_MMA
#undef PG8_WAIT_V
#undef PG8_WAIT_L
#undef PG8_BAR
#undef PG8_SCHED
}
}
using pg8::bf16_t; using pg8::bf16x8; using pg8::f32x4; using pg8::u32x4;
#define LDSP __attribute__((address_space(3)))
typedef float f32x16 __attribute__((ext_vector_type(16)));
typedef float f32x2v __attribute__((ext_vector_type(2)));
typedef __bf16 bf16v2 __attribute__((ext_vector_type(2)));
typedef unsigned u32x2 __attribute__((ext_vector_type(2)));

constexpr int S = 16384, DM = 4096, DFF = 11008;
constexpr int ABW = 6912, NSW = 5728, NSWP = 5888;
constexpr float EPS = 1e-5f, SCALE = 0.08838834764831845f, LOG2E = 1.4426950408889634f, C2 = SCALE * LOG2E;
constexpr int NCMP = 1023, NCMPP = 1024;

constexpr size_t AL(size_t x) { return (x + 4095) & ~(size_t)4095; }
constexpr size_t OFF_BAR    = 0;
constexpr size_t OFF_DBG    = 16384;
constexpr size_t OFF_WT_ABIN  = 65536;
constexpr size_t OFF_WT_ABOUT = OFF_WT_ABIN  + AL((size_t)ABW * DM * 2);
constexpr size_t OFF_WT_GU0   = OFF_WT_ABOUT + AL((size_t)DM * DM * 2);
constexpr size_t OFF_WT_GU1   = OFF_WT_GU0   + AL((size_t)2 * DFF * DM * 2);
constexpr size_t OFF_WT_DN0   = OFF_WT_GU1   + AL((size_t)2 * DFF * DM * 2);
constexpr size_t OFF_WT_DN1   = OFF_WT_DN0   + AL((size_t)DM * DFF * 2);
constexpr size_t OFF_WT_NSIN  = OFF_WT_DN1   + AL((size_t)DM * DFF * 2);
constexpr size_t OFF_WT_NSOUT = OFF_WT_NSIN  + AL((size_t)NSWP * DM * 2);
constexpr size_t OFF_HB     = OFF_WT_NSOUT + AL((size_t)DM * DM * 2);
constexpr size_t OFF_OB     = OFF_HB   + AL((size_t)S * DM * 2);
constexpr size_t OFF_QKV    = OFF_OB   + AL((size_t)S * DM * 2);
constexpr size_t OFF_HID    = OFF_QKV  + AL((size_t)S * ABW * 2);
constexpr size_t OFF_X1     = OFF_HID  + AL((size_t)S * DFF * 2);
constexpr size_t OFF_X2     = OFF_X1   + AL((size_t)S * DM * 4);
constexpr size_t OFF_OACC   = OFF_X2   + AL((size_t)S * DM * 4);
constexpr size_t OFF_VTA    = OFF_OACC + AL((size_t)S * DM * 4);
constexpr size_t OFF_VTB    = OFF_VTA  + AL((size_t)1024 * S * 2);
constexpr size_t OFF_VTS    = OFF_VTB  + AL((size_t)384 * S * 2);
constexpr size_t OFF_VTW    = OFF_VTS  + AL((size_t)256 * S * 2);
constexpr size_t OFF_KCMP   = OFF_VTW  + AL((size_t)256 * S * 2);
constexpr size_t OFF_VCMPT  = OFF_KCMP + AL((size_t)2 * NCMPP * 128 * 2);
constexpr size_t OFF_IDX    = OFF_VCMPT + AL((size_t)2 * NCMPP * 128 * 2);
constexpr size_t OFF_SCR    = OFF_IDX  + AL((size_t)S * 2 * 8 * 4);
constexpr size_t WS_NEED    = OFF_SCR  + AL((size_t)64 << 20);

__device__ __forceinline__ unsigned pk2(float a, float b) { f32x2v v = {a, b}; return __builtin_bit_cast(unsigned, __builtin_convertvector(v, bf16v2)); }
__device__ __forceinline__ float bf2f(bf16_t x) { return __uint_as_float(((unsigned)x) << 16); }
__device__ __forceinline__ float ex2(float x) { return __builtin_amdgcn_exp2f(x); }
__device__ __forceinline__ float lg2(float x) { return __builtin_amdgcn_logf(x); }
__device__ __forceinline__ float sigmoidf_(float x) { return __builtin_amdgcn_rcpf(1.f + ex2(-x * LOG2E)); }
#define GAS __attribute__((address_space(1)))
template <class T> __device__ __forceinline__ T gld(const T* p) { return *(const GAS T*)p; }
template <class T> __device__ __forceinline__ T gldnt(const T* p) { return __builtin_nontemporal_load((const GAS T*)p); }
template <class T> __device__ __forceinline__ void gst(T* p, const T v) { *(GAS T*)p = v; }
template <class T> __device__ __forceinline__ void gstnt(T* p, const T v) { __builtin_nontemporal_store(v, (GAS T*)p); }
__device__ __forceinline__ float max3f(float a, float b, float c) { float d; asm("v_max3_f32 %0, %1, %2, %3" : "=v"(d) : "v"(a), "v"(b), "v"(c)); return d; }
#define MFMA32(a, b, c) __builtin_amdgcn_mfma_f32_32x32x16_bf16((a), (b), (c), 0, 0, 0)
#define MFMA16(a, b, c) __builtin_amdgcn_mfma_f32_16x16x32_bf16((a), (b), (c), 0, 0, 0)
struct EpiBf16 {
    static constexpr bool PERM = true, AFTER_DRAIN = false;
    bf16_t* O; bf16_t* vtA; bf16_t* vtB; unsigned* kpart; unsigned* kpartB; int ldc, va0, va1, vb0, vb1, k0, k1, k2, k3, pad_;
    __device__ __forceinline__ void operator()(const f32x4 (&acc)[2][2][4][2], const pg8::Unit& u, int wr, int wc, int fr, int fq) const {
        const int row0 = u.pm * 256 + wr * 64 + fr, col0 = u.pn * 256 + wc * 32 + 8 * fq;
#pragma unroll
        for (int bj = 0; bj < 2; ++bj) {
            const int colh = u.pn * 256 + bj * 128;
            bf16_t* vt = nullptr; int cb = 0;
            if (colh >= va0 && colh < va1) { vt = vtA; cb = colh - va0; } else if (colh >= vb0 && colh < vb1) { vt = vtB; cb = colh - vb0; }
            if (vt) {
                bf16_t* vp = vt + (size_t)(cb + wc * 32 + 8 * fq) * S + row0;
#pragma unroll
                for (int ai = 0; ai < 2; ++ai)
#pragma unroll
                    for (int m = 0; m < 4; ++m)
#pragma unroll
                        for (int n = 0; n < 2; ++n) { const f32x4 v = acc[ai][bj][m][n]; const unsigned w0 = pk2(v[0], v[1]), w1 = pk2(v[2], v[3]);
                            bf16_t* q = vp + (size_t)(4 * n) * S + ai * 128 + m * 16;
                            gst(q, (bf16_t)(w0 & 0xffffu)); gst(q + S, (bf16_t)(w0 >> 16)); gst(q + 2 * (size_t)S, (bf16_t)(w1 & 0xffffu)); gst(q + 3 * (size_t)S, (bf16_t)(w1 >> 16)); }
            } else {
                float kmx = 0.f; const bool knA = colh >= k0 && colh < k1, kn = knA || (colh >= k2 && colh < k3);
#pragma unroll
                for (int ai = 0; ai < 2; ++ai)
#pragma unroll
                    for (int m = 0; m < 4; ++m) { const f32x4 v0 = acc[ai][bj][m][0], v1 = acc[ai][bj][m][1];
                        u32x4 w; w.x = pk2(v0[0], v0[1]); w.y = pk2(v0[2], v0[3]); w.z = pk2(v1[0], v1[1]); w.w = pk2(v1[2], v1[3]);
                        gst((u32x4*)(O + (size_t)(row0 + ai * 128 + m * 16) * ldc + col0 + bj * 128), (u32x4)(w));
                        if (kn) { float ss = 0.f;
#pragma unroll
                            for (int e = 0; e < 4; ++e) { const float lo = __uint_as_float(w[e] << 16), hi = __uint_as_float(w[e] & 0xffff0000u); ss += lo * lo + hi * hi; }
                            ss += __shfl_xor(ss, 16); ss += __shfl_xor(ss, 32); kmx = fmaxf(kmx, ss); } }
                if (kn) {
#pragma unroll
                    for (int o_ = 8; o_ >= 1; o_ >>= 1) kmx = fmaxf(kmx, __shfl_xor(kmx, o_));
                    if ((fr | fq) == 0) atomicMax(knA ? kpart + ((colh - k0) >> 7) * 4 + wc : kpartB + ((colh - k2) >> 7) * 4 + wc, __float_as_uint(kmx)); }
            }
        }
    }
};
struct EpiRes {
    static constexpr bool PERM = true, AFTER_DRAIN = false;
    const bf16_t* base; bf16_t* out; int ldc, pad_;
    __device__ __forceinline__ void operator()(const f32x4 (&acc)[2][2][4][2], const pg8::Unit& u, int wr, int wc, int fr, int fq) const {
        const int row0 = u.pm * 256 + wr * 64 + fr, col0 = u.pn * 256 + wc * 32 + 8 * fq;
        u32x4 b[2][4][2];
#pragma unroll
        for (int ai = 0; ai < 2; ++ai)
#pragma unroll
            for (int m = 0; m < 4; ++m)
#pragma unroll
                for (int bj = 0; bj < 2; ++bj) b[ai][m][bj] = gldnt((const u32x4*)(base + (size_t)(row0 + ai * 128 + m * 16) * ldc + col0 + bj * 128));
        asm volatile("" ::: "memory");
#pragma unroll
        for (int ai = 0; ai < 2; ++ai)
#pragma unroll
            for (int m = 0; m < 4; ++m)
#pragma unroll
                for (int bj = 0; bj < 2; ++bj) { const f32x4 v0 = acc[ai][bj][m][0], v1 = acc[ai][bj][m][1]; const u32x4 r = b[ai][m][bj]; u32x4 w;
                    w.x = pk2(v0[0] + __uint_as_float(r.x << 16), v0[1] + __uint_as_float(r.x & 0xffff0000u)); w.y = pk2(v0[2] + __uint_as_float(r.y << 16), v0[3] + __uint_as_float(r.y & 0xffff0000u));
                    w.z = pk2(v1[0] + __uint_as_float(r.z << 16), v1[1] + __uint_as_float(r.z & 0xffff0000u)); w.w = pk2(v1[2] + __uint_as_float(r.w << 16), v1[3] + __uint_as_float(r.w & 0xffff0000u));
                    gst((u32x4*)(out + (size_t)(row0 + ai * 128 + m * 16) * ldc + col0 + bj * 128), (u32x4)(w)); }
    }
};
struct EpiSwiGLU {
    static constexpr bool PERM = true, AFTER_DRAIN = false;
    bf16_t* H; int ldh, tiled;
    __device__ __forceinline__ void operator()(const f32x4 (&acc)[2][2][4][2], const pg8::Unit& u, int wr, int wc, int fr, int fq) const {
        const int row0 = u.pm * 256 + wr * 64 + fr, col0 = u.pn * 128 + wc * 32 + 8 * fq;
#pragma unroll
        for (int ai = 0; ai < 2; ++ai)
#pragma unroll
            for (int m = 0; m < 4; ++m) { const int rr = wr * 64 + fr + ai * 128 + m * 16;
                bf16_t* rowp = tiled ? H + ((size_t)(u.pm * (ldh >> 6) + (col0 >> 6)) * 256 + rr) * 64 + (col0 & 63) : H + (size_t)(row0 + ai * 128 + m * 16) * ldh + col0;
                float hv[8];
#pragma unroll
                for (int n = 0; n < 2; ++n)
#pragma unroll
                    for (int e = 0; e < 4; ++e) { const float gt = acc[ai][0][m][n][e], up = acc[ai][1][m][n][e]; hv[n * 4 + e] = gt * sigmoidf_(gt) * up; }
                u32x4 w; w.x = pk2(hv[0], hv[1]); w.y = pk2(hv[2], hv[3]); w.z = pk2(hv[4], hv[5]); w.w = pk2(hv[6], hv[7]);
                gstnt((u32x4*)rowp, (u32x4)(w)); }
    }
};

struct CvtJob { const float* src; bf16_t* dst; int K, N, Nout, mode, tile0, ntn; };
constexpr int NCVT = 12;
struct CvtJobs { CvtJob j[NCVT]; int total; int pad_; };
__device__ __forceinline__ void cvt_phase(const CvtJobs& js, LDSP char* lds, int bid, int nb) {
    LDSP float* tb = (LDSP float*)lds;
    const int tid = tid_l();
    f32x4 v[4][2]; bf16_t* dp[4];
    auto issue = [&](int T0) {
#pragma unroll
        for (int q = 0; q < 4; ++q) {
            const int T = T0 + q * nb; dp[q] = nullptr;
#pragma unroll
            for (int i = 0; i < 2; ++i) v[q][i] = (f32x4){0.f, 0.f, 0.f, 0.f};
            if (T < js.total) {
                int ji = 0;
#pragma unroll
                for (int k = 1; k < NCVT; ++k) if (T >= js.j[k].tile0) ji = k;
                const CvtJob& J = js.j[ji]; const int lt = T - J.tile0, tn = lt % J.ntn, tk = lt / J.ntn, rho0 = tn * 64;
                int col0;
                if (J.mode & 1) { const int pn = rho0 >> 8, bj = (rho0 >> 7) & 1, cc = rho0 & 127; col0 = bj * DFF + pn * 128 + cc; } else col0 = rho0;
#pragma unroll
                for (int i = 0; i < 2; ++i) { const int idx = tid + 512 * i, kr = idx >> 4, c4 = (idx & 15) * 4;
                    if (col0 + c4 < J.N) v[q][i] = gldnt((const f32x4*)(J.src + (size_t)(tk * 64 + kr) * J.N + col0 + c4)); }
                { const int rho = rho0 + (tid >> 3);
                  dp[q] = (J.mode & 2) ? J.dst + ((size_t)((rho >> 8) * (J.K >> 6) + tk) * 256 + (rho & 255)) * 64 + (tid & 7) * 8 : J.dst + (size_t)rho * J.K + tk * 64 + (tid & 7) * 8; }
            }
        } };
    int T0 = bid;
    if (T0 < js.total) issue(T0);
    for (; T0 < js.total; T0 += 4 * nb) {
        bf16_t* dpc[4];
#pragma unroll
        for (int q = 0; q < 4; ++q) dpc[q] = dp[q];
#pragma unroll
        for (int q = 0; q < 4; ++q)
#pragma unroll
            for (int i = 0; i < 2; ++i) { const int idx = tid + 512 * i, kr = idx >> 4, c4 = (idx & 15) * 4; LDSP float* t = tb + q * (64 * 65) + kr * 65 + c4;
                t[0] = v[q][i][0]; t[1] = v[q][i][1]; t[2] = v[q][i][2]; t[3] = v[q][i][3]; }
        __syncthreads();
        if (T0 + 4 * nb < js.total) issue(T0 + 4 * nb);
#pragma unroll
        for (int q = 0; q < 4; ++q) if (dpc[q]) { const int nn = tid >> 3, k8 = (tid & 7) * 8; const LDSP float* t = tb + q * (64 * 65); float f[8];
#pragma unroll
            for (int e = 0; e < 8; ++e) f[e] = t[(k8 + e) * 65 + nn];
            u32x4 w; w.x = pk2(f[0], f[1]); w.y = pk2(f[2], f[3]); w.z = pk2(f[4], f[5]); w.w = pk2(f[6], f[7]);
            gstnt((u32x4*)dpc[q], (u32x4)(w)); }
        __syncthreads();
    }
}

template <bool F32OUT, bool BFIN, bool COPY>
__device__ __forceinline__ void rmsnorm_phase(const void* x, const float* g, bf16_t* hb, float* hf, bf16_t* xc, int bid, int nb) {
    const int wid = tid_l() >> 6, lane = tid_l() & 63;
    u32x4 rn[8];
    if (BFIN) { const int row = bid * 8 + wid;
        if (row < S) {
#pragma unroll
            for (int j = 0; j < 8; ++j) rn[j] = gld((const u32x4*)((const bf16_t*)x + (size_t)row * DM + (j * 64 + lane) * 8)); } }
    for (int row = bid * 8 + wid; row < S; row += nb * 8) {
        f32x4 v[8][2]; float ss = 0.f;
        if (BFIN) {
#pragma unroll
            for (int j = 0; j < 8; ++j) { const u32x4 r = rn[j];
                v[j][0] = (f32x4){__uint_as_float(r.x << 16), __uint_as_float(r.x & 0xffff0000u), __uint_as_float(r.y << 16), __uint_as_float(r.y & 0xffff0000u)};
                v[j][1] = (f32x4){__uint_as_float(r.z << 16), __uint_as_float(r.z & 0xffff0000u), __uint_as_float(r.w << 16), __uint_as_float(r.w & 0xffff0000u)}; }
            const int nrow = row + nb * 8;
            if (nrow < S) {
#pragma unroll
                for (int j = 0; j < 8; ++j) rn[j] = gld((const u32x4*)((const bf16_t*)x + (size_t)nrow * DM + (j * 64 + lane) * 8)); }
        } else { const float* xr = (const float*)x + (size_t)row * DM;
#pragma unroll
            for (int j = 0; j < 8; ++j) { v[j][0] = gldnt((const f32x4*)(xr + (j * 64 + lane) * 8)); v[j][1] = gldnt((const f32x4*)(xr + (j * 64 + lane) * 8 + 4)); } }
#pragma unroll
        for (int j = 0; j < 8; ++j)
#pragma unroll
            for (int q = 0; q < 2; ++q) ss += v[j][q][0] * v[j][q][0] + v[j][q][1] * v[j][q][1] + v[j][q][2] * v[j][q][2] + v[j][q][3] * v[j][q][3];
#pragma unroll
        for (int o = 32; o >= 1; o >>= 1) ss += __shfl_xor(ss, o);
        const float rstd = 1.0f / sqrtf(ss * (1.0f / DM) + EPS);
#pragma unroll
        for (int j = 0; j < 8; ++j) { const int c = (j * 64 + lane) * 8;
            if (COPY) { u32x4 w; w.x = pk2(v[j][0][0], v[j][0][1]); w.y = pk2(v[j][0][2], v[j][0][3]); w.z = pk2(v[j][1][0], v[j][1][1]); w.w = pk2(v[j][1][2], v[j][1][3]); gst((u32x4*)(xc + (size_t)row * DM + c), (u32x4)(w)); }
            const f32x4 y0 = v[j][0] * rstd * gld((const f32x4*)(g + c)), y1 = v[j][1] * rstd * gld((const f32x4*)(g + c + 4));
            if (F32OUT) { gstnt((f32x4*)(hf + (size_t)row * DM + c), (f32x4)(y0)); gstnt((f32x4*)(hf + (size_t)row * DM + c + 4), (f32x4)(y1)); }
            else { u32x4 w; w.x = pk2(y0[0], y0[1]); w.y = pk2(y0[2], y0[3]); w.z = pk2(y1[0], y1[1]); w.w = pk2(y1[2], y1[3]); gst((u32x4*)(hb + (size_t)row * DM + c), (u32x4)(w)); } }
    }
}
constexpr int KROW = 272, VROW = 144, KT_BYTES = 64 * KROW, VT_BYTES = 128 * VROW;
__device__ __forceinline__ int kperm_row(int kap) { const int i = kap & 15; return (kap & 32) + (i & 3) + 8 * (i >> 2) + 4 * ((kap >> 4) & 1); }

struct TileRegs { u32x4 k0, k1, v0, v1; };
constexpr int TB_BYTES = KT_BYTES + VT_BYTES;
__device__ __forceinline__ void g_load_k(TileRegs& R, const bf16_t* Kg, size_t ldk, int kbase, int tid) {
    const char* base = (const char*)(Kg + (size_t)kbase * ldk);
    const unsigned o0 = ((unsigned)(tid >> 4) * (unsigned)ldk + (unsigned)(tid & 15) * 8u) * 2u;
    R.k0 = gld((const u32x4*)(base + o0));
    R.k1 = gld((const u32x4*)(base + (o0 + 64u * (unsigned)ldk)));
}
__device__ __forceinline__ void g_load_v(TileRegs& R, const bf16_t* VTg, size_t ldv, int kbase, int tid) {
    const char* base = (const char*)(VTg + kbase);
    const unsigned o0 = ((unsigned)(tid >> 3) * (unsigned)ldv + (unsigned)(tid & 7) * 8u) * 2u;
    R.v0 = gld((const u32x4*)(base + o0));
    R.v1 = gld((const u32x4*)(base + (o0 + 128u * (unsigned)ldv)));
}
__device__ __forceinline__ void s_store_k(LDSP char* kl, const TileRegs& R, int tid) {
    const int row = tid >> 4, c16 = tid & 15;
    *(LDSP u32x4*)(kl + kperm_row(row) * KROW + c16 * 16) = R.k0;
    *(LDSP u32x4*)(kl + kperm_row(row + 32) * KROW + c16 * 16) = R.k1;
}
__device__ __forceinline__ void s_store_v(LDSP char* vl, const TileRegs& R, int tid) {
    const int row = tid >> 3, c16 = tid & 7;
    *(LDSP u32x4*)(vl + row * VROW + c16 * 16) = R.v0;
    *(LDSP u32x4*)(vl + (64 + row) * VROW + c16 * 16) = R.v1;
}
__device__ __forceinline__ void qk_tile(f32x16& p0, f32x16& p1, const LDSP char* kl, const bf16x8 (&qr)[8], int r, int h) {
#pragma unroll
    for (int i = 0; i < 16; ++i) { p0[i] = 0.f; p1[i] = 0.f; }
    const LDSP char* a = kl + r * KROW + h * 16;
    __builtin_amdgcn_s_setprio(1);
#pragma unroll
    for (int d0 = 0; d0 < 8; ++d0) {
        const bf16x8 a0 = *(const LDSP bf16x8*)(a + d0 * 32);
        const bf16x8 a1 = *(const LDSP bf16x8*)(a + 32 * KROW + d0 * 32);
        p0 = MFMA32(a0, qr[d0], p0); p1 = MFMA32(a1, qr[d0], p1);
        if (d0 & 1) asm volatile("" ::: "memory"); }
    __builtin_amdgcn_s_setprio(0);
}
__device__ __forceinline__ bf16x8 pack8(const f32x16& p, int s8) {
    u32x4 w; w.x = pk2(p[s8 + 0], p[s8 + 1]); w.y = pk2(p[s8 + 2], p[s8 + 3]); w.z = pk2(p[s8 + 4], p[s8 + 5]); w.w = pk2(p[s8 + 6], p[s8 + 7]);
    return __builtin_bit_cast(bf16x8, w);
}
__device__ __forceinline__ void pv_tile(f32x16 (&o)[4], const f32x16& p0, const f32x16& p1, const LDSP char* vl, int r, int h) {
    __builtin_amdgcn_s_setprio(1);
#pragma unroll
    for (int kb = 0; kb < 2; ++kb)
#pragma unroll
        for (int s = 0; s < 2; ++s) {
            const bf16x8 pb = kb ? pack8(p1, 8 * s) : pack8(p0, 8 * s);
#pragma unroll
            for (int d0 = 0; d0 < 4; ++d0) {
                const bf16x8 a = *(const LDSP bf16x8*)(vl + (32 * d0 + r) * VROW + (32 * kb + 16 * h + 8 * s) * 2);
                o[d0] = MFMA32(a, pb, o[d0]); }
            asm volatile("" ::: "memory"); }
    __builtin_amdgcn_s_setprio(0);
}
__device__ __forceinline__ void pv_tile_packed(f32x16 (&o)[4], const bf16x8 (&P)[4], const LDSP char* vl, int r, int h) {
    __builtin_amdgcn_s_setprio(1);
#pragma unroll
    for (int g = 0; g < 4; ++g) {
#pragma unroll
        for (int d0 = 0; d0 < 4; ++d0) {
            const bf16x8 a = *(const LDSP bf16x8*)(vl + (32 * d0 + r) * VROW + (32 * (g >> 1) + 16 * h + 8 * (g & 1)) * 2);
            o[d0] = MFMA32(a, P[g], o[d0]); }
        asm volatile("" ::: "memory"); }
    __builtin_amdgcn_s_setprio(0);
}
__device__ __forceinline__ void load_q(bf16x8 (&qr)[8], const bf16_t* qp  ) {
#pragma unroll
    for (int d0 = 0; d0 < 8; ++d0) qr[d0] = gld((const bf16x8*)(qp + 16 * d0));
}


template <int STRIDE, bool NEEDMAX = true>
__device__ __forceinline__ void tile_scores(f32x16& p0, f32x16& p1, float slope2, int tb, unsigned W, float& mx, float off = 0.f) {
    const float NINF = -__builtin_inff();
    const float cs = slope2 * (float)STRIDE, c0 = -slope2 * (float)tb - off, c1 = c0 + cs * 32.f;
#pragma unroll
    for (int i = 0; i < 16; ++i) { p0[i] = fmaf(p0[i], C2, fmaf(cs, (float)i, c0)); p1[i] = fmaf(p1[i], C2, fmaf(cs, (float)i, c1)); }
    if (!__all((tb - 47 * STRIDE >= 0) && ((unsigned)tb < W))) {
#pragma unroll
        for (int i = 0; i < 16; ++i) { p0[i] = ((unsigned)(tb - STRIDE * i) < W) ? p0[i] : NINF; p1[i] = ((unsigned)(tb - STRIDE * (32 + i)) < W) ? p1[i] : NINF; }
    }
    if (NEEDMAX) {
#pragma unroll
        for (int i = 0; i < 16; ++i) mx = max3f(mx, p0[i], p1[i]); }
}
constexpr float ZB_FAST = 60.f;
__device__ __forceinline__ void exp_acc(f32x16& p0, f32x16& p1, f32x2v& lacc) {
#pragma unroll
    for (int i = 0; i < 16; i += 2) {
        f32x2v a, b; a.x = ex2(p0[i]); a.y = ex2(p0[i + 1]); b.x = ex2(p1[i]); b.y = ex2(p1[i + 1]);
        p0[i] = a.x; p0[i + 1] = a.y; p1[i] = b.x; p1[i + 1] = b.y;
        lacc += a; lacc += b; }
}
__device__ __forceinline__ void softmax_upd(f32x16& p0, f32x16& p1, float mx, float& m, float& l, f32x16 (&o)[4]) {
    mx = fmaxf(mx, __shfl_xor(mx, 32));
    const float mn = fmaxf(m, mx), alpha = ex2(m - mn); m = mn;
    f32x2v acc = {0.f, 0.f};
#pragma unroll
    for (int i = 0; i < 16; i += 2) {
        f32x2v a = {p0[i], p0[i + 1]}, b = {p1[i], p1[i + 1]};
        a = a - mn; b = b - mn;
        a.x = ex2(a.x); a.y = ex2(a.y); b.x = ex2(b.x); b.y = ex2(b.y);
        p0[i] = a.x; p0[i + 1] = a.y; p1[i] = b.x; p1[i + 1] = b.y;
        acc += a; acc += b; }
    float ps = acc.x + acc.y; ps += __shfl_xor(ps, 32);
    l = l * alpha + ps;
    if (!__all(alpha == 1.f)) {
#pragma unroll
        for (int d0 = 0; d0 < 4; ++d0)
#pragma unroll
            for (int i = 0; i < 16; ++i) o[d0][i] *= alpha; }
}
__device__ __forceinline__ void softmax_pv(f32x16& p0, f32x16& p1, float mx, float& m, float& l, f32x16 (&o)[4], const LDSP char* vl, int r, int h) {
    softmax_upd(p0, p1, mx, m, l, o); pv_tile(o, p0, p1, vl, r, h);
}
constexpr int KBUF0 = 0, VBUF0 = 2 * KT_BYTES, AUX_OFF = 2 * KT_BYTES + 3 * VT_BYTES, NSA_SB_OFF = AUX_OFF + 2048;
template <class Seq, class Score>
__device__ __forceinline__ void attn_stream(const Seq& seq, const Score& score, const bf16_t* Kg, size_t ldk, const bf16_t* Vg, size_t ldv, const bf16x8 (&qr)[8],
                                            float& m, float& l, f32x16 (&o)[4], LDSP char* lds, int tid, int r, int h, bool grpB, bool fast) {
    TileRegs R; int kb = 0, vb = 0, vprev = 0; bool pend = false; bf16x8 P[4]; f32x2v lacc = {0.f, 0.f};
    int t = seq.first();
    g_load_k(R, Kg, ldk, seq.base(t), tid); g_load_v(R, Vg, ldv, seq.base(t), tid);
    s_store_k(lds + KBUF0, R, tid); s_store_v(lds + VBUF0, R, tid);
    __syncthreads();
    while (t >= 0) {
        const LDSP char* kl = lds + KBUF0 + kb * KT_BYTES; const LDSP char* vl = lds + VBUF0 + vb * VT_BYTES;
        const int tn = seq.next(t);
        if (tn >= 0) { g_load_k(R, Kg, ldk, seq.base(tn), tid); g_load_v(R, Vg, ldv, seq.base(tn), tid); }
        if (grpB && pend) { pv_tile_packed(o, P, lds + VBUF0 + vprev * VT_BYTES, r, h); pend = false; }
        f32x16 p0, p1; qk_tile(p0, p1, kl, qr, r, h);
        float mx = -__builtin_inff();
        if (score(p0, p1, t, mx)) {
            if (fast) exp_acc(p0, p1, lacc); else softmax_upd(p0, p1, mx, m, l, o);
            P[0] = pack8(p0, 0); P[1] = pack8(p0, 8); P[2] = pack8(p1, 0); P[3] = pack8(p1, 8);
            if (grpB) { pend = true; vprev = vb; } else pv_tile_packed(o, P, vl, r, h);
        }
        const int vn = vb == 2 ? 0 : vb + 1;
        if (tn >= 0) { s_store_k(lds + KBUF0 + (kb ^ 1) * KT_BYTES, R, tid); s_store_v(lds + VBUF0 + vn * VT_BYTES, R, tid); }
        __syncthreads(); kb ^= 1; vb = vn; t = tn;
    }
    if (grpB && pend) pv_tile_packed(o, P, lds + VBUF0 + vprev * VT_BYTES, r, h);
    if (fast) { float ps = lacc.x + lacc.y; ps += __shfl_xor(ps, 32); l += ps; }
    __syncthreads();
}
__device__ __forceinline__ float sb_block_prod(f32x16& p, int kpos0, int t, float cP, int h, bool interior) {
    if (!interior) {
#pragma unroll
        for (int i = 0; i < 16; ++i) p[i] = ((kpos0 + i) < t) ? p[i] : -__builtin_inff(); }
    float run = 1.f;
#pragma unroll
    for (int i = 15; i >= 0; --i) {
        const float e = fminf(ex2(p[i] * C2), 1.8446744e19f), nb = __builtin_amdgcn_rcpf(1.f + e);
        run *= nb; p[i] = e * run; }
    const float T = run, PT = __shfl_xor(T, 32);
    const float sc = cP * (h == 0 ? PT : 1.f);
#pragma unroll
    for (int i = 0; i < 16; ++i) p[i] *= sc;
    return T * PT;
}
__device__ __forceinline__ void sb_unit(const bf16_t* qkv, const bf16_t* vta, bf16_t* ob, const float* kmax2, int head, int qb, LDSP char* lds) {
    const int tid = tid_l(), wid = __builtin_amdgcn_readfirstlane(tid >> 6), lane = tid & 63, r = lane & 31, h = lane >> 5;
    const int t0 = qb * 256, tq0 = t0 + 32 * wid, t = tq0 + r;
    LDSP int* votes = (LDSP int*)(lds + 2 * TB_BYTES);
    bf16x8 qr[8]; load_q(qr, qkv + (size_t)t * ABW + head * 128 + 8 * h);
    float qn2 = 0.f;
#pragma unroll
    for (int d0 = 0; d0 < 8; ++d0)
#pragma unroll
        for (int e = 0; e < 8; ++e) { const float v = bf2f((bf16_t)qr[d0][e]); qn2 += v * v; }
    qn2 += __shfl_xor(qn2, 32);
    const float km2 = (gld(kmax2 + 4 * head) + gld(kmax2 + 4 * head + 1)) + (gld(kmax2 + 4 * head + 2) + gld(kmax2 + 4 * head + 3));
    const float zb = sqrtf(qn2 * km2) * C2 * 1.001f + 1.0f;
    const bf16_t* Kg = qkv + 1024 + head * 128;
    const bf16_t* Vg = vta + (size_t)head * 128 * S;
    f32x16 o[4];
#pragma unroll
    for (int d0 = 0; d0 < 4; ++d0)
#pragma unroll
        for (int i = 0; i < 16; ++i) o[d0][i] = 0.f;
    float carry = 0.f;
    if (lane < 2) votes[lane * 8 + wid] = 0;
    const int jhi = (t0 + 254) >> 6;
    TileRegs R; int buf = 0, done = 0;
    g_load_k(R, Kg, ABW, jhi * 64, tid); g_load_v(R, Vg, S, jhi * 64, tid);
    s_store_k(lds, R, tid); s_store_v(lds + KT_BYTES, R, tid);
    __syncthreads();
    for (int j = jhi; j >= 0; --j) {
        const LDSP char* kl = lds + buf * TB_BYTES; const LDSP char* vl = kl + KT_BYTES;
        if (j > 0) { g_load_k(R, Kg, ABW, (j - 1) * 64, tid); g_load_v(R, Vg, S, (j - 1) * 64, tid); }
        if (!done && j * 64 < tq0 + 31) {
            f32x16 p0, p1; qk_tile(p0, p1, kl, qr, r, h);
            const float cP = ex2(carry); float b1, b0;
            const bool interior = j * 64 + 63 < tq0;
            b1 = sb_block_prod(p1, j * 64 + 32 + 16 * h, t, cP, h, interior); b0 = sb_block_prod(p0, j * 64 + 16 * h, t, cP * b1, h, interior);
            carry += lg2(b1 * b0);
            pv_tile(o, p0, p1, vl, r, h);
            done = __all(carry + zb < -140.f) ? 1 : 0;
        }
        if (lane == 0) votes[(j & 1) * 8 + wid] = done;
        if (j > 0) { s_store_k(lds + (buf ^ 1) * TB_BYTES, R, tid); s_store_v(lds + (buf ^ 1) * TB_BYTES + KT_BYTES, R, tid); }
        __syncthreads();
        { int all = 1;
#pragma unroll
          for (int w = 0; w < 8; ++w) all &= votes[(j & 1) * 8 + w];
          if (all) break; }
        buf ^= 1;
    }
    __syncthreads();
    bf16_t* op = ob + (size_t)t * DM + head * 128 + 4 * h;
#pragma unroll
    for (int d0 = 0; d0 < 4; ++d0)
#pragma unroll
        for (int g = 0; g < 4; ++g) { u32x2 w; w.x = pk2(o[d0][4 * g], o[d0][4 * g + 1]); w.y = pk2(o[d0][4 * g + 2], o[d0][4 * g + 3]); gst((u32x2*)(op + 32 * d0 + 8 * g), (u32x2)(w)); }
}
template <int W, bool SINK, bool NSAWIN>
__device__ __forceinline__ void win_unit(const bf16_t* qkv, int ld, int qcol, int kcol, const bf16_t* vt, float slope, float sinkv, float gate,
                                         const float* oacc, const float* oslc, bf16_t* ob, int ocol, int qt, LDSP char* lds) {
    const int tid = tid_l(), lane = tid & 63, r = lane & 31, h = lane >> 5;
    const int t0 = qt * 32, t = t0 + r;
    bf16x8 qr[8]; load_q(qr, qkv + (size_t)t * ld + qcol + 8 * h);
    const float slope2 = slope * LOG2E;
    float m = SINK ? sinkv * LOG2E : -1e30f, l = SINK ? 1.f : 0.f;
    f32x16 o[4];
#pragma unroll
    for (int d0 = 0; d0 < 4; ++d0)
#pragma unroll
        for (int i = 0; i < 16; ++i) o[d0][i] = 0.f;
    int lowk = t0 - (W - 1); if (lowk < 0) lowk = 0;
    const int jlo = lowk >> 6, jhi = (t0 + 31) >> 6;
    struct Seq { int lo, hi; __device__ int first() const { return hi; } __device__ int next(int t_) const { return t_ > lo ? t_ - 1 : -1; } __device__ int base(int t_) const { return t_ * 64; } } seq{jlo, jhi};
    auto score = [&](f32x16& p0, f32x16& p1, int tl, float& mx) { tile_scores<1>(p0, p1, slope2, t - tl * 64 - 16 * h, (unsigned)W, mx); return true; };
    attn_stream(seq, score, qkv + kcol, (size_t)ld, vt, (size_t)S, qr, m, l, o, lds, tid, r, h, (tid >> 8) != 0, false);
    const float inv = (NSAWIN ? gate : 1.f) / l;
    bf16_t* op = ob + (size_t)t * DM + ocol + 4 * h;
    const float* ap = oacc + (size_t)t * DM + ocol + 4 * h;
    const float* sp = oslc + (size_t)t * DM + ocol + 4 * h;
#pragma unroll
    for (int d0 = 0; d0 < 4; ++d0)
#pragma unroll
        for (int g = 0; g < 4; ++g) {
            f32x4 v = {o[d0][4 * g] * inv, o[d0][4 * g + 1] * inv, o[d0][4 * g + 2] * inv, o[d0][4 * g + 3] * inv};
            if (NSAWIN) v += gld((const f32x4*)(ap + 32 * d0 + 8 * g)) + gld((const f32x4*)(sp + 32 * d0 + 8 * g));
            u32x2 w; w.x = pk2(v[0], v[1]); w.y = pk2(v[2], v[3]); gst((u32x2*)(op + 32 * d0 + 8 * g), (u32x2)(w)); }
}
__device__ __forceinline__ float slope_l0(int kvh, int g) { return exp2f(-8.f * (float)(3 * g + kvh + 1) / 24.f); }
__device__ __forceinline__ float slope_l1(int kvh, int g) { return exp2f(-8.f * (float)(2 * g + kvh + 1) / 32.f); }

#define LADD(p, v) ((void)__hip_atomic_fetch_add((p), (v), __ATOMIC_RELAXED, __HIP_MEMORY_SCOPE_WORKGROUP))
__device__ __forceinline__ float gelu_tanh(float x) { const float u = 0.7978845608028654f * (x + 0.044715f * x * x * x); const float e = ex2(-2.f * LOG2E * fabsf(u)); const float th = (1.f - e) / (1.f + e); return 0.5f * x * (1.f + (u < 0.f ? -th : th)); }

__device__ __forceinline__ int prev_bit(const LDSP unsigned* bm, int from) {
    if (from < 0) return -1;
    int w = from >> 5; unsigned word = bm[w] & (0xffffffffu >> (31 - (from & 31)));
    while (!word && --w >= 0) word = bm[w];
    return word ? w * 32 + (31 - __builtin_clz(word)) : -1;
}

__device__ __forceinline__ void nsa_unit(const bf16_t* qkv, const bf16_t* kcmp, const bf16_t* vcmpt, const bf16_t* vts, const bf16_t* vtw, const float* kb, bf16_t* ob, int kvh, int qt, LDSP char* lds) {
    const int tid = tid_l(), wid = __builtin_amdgcn_readfirstlane(tid >> 6), lane = tid & 63, r = lane & 31, h = lane >> 5;
    const int t0 = qt * 32, t = t0 + r;
    LDSP int* idl = (LDSP int*)(lds + AUX_OFF);
    LDSP unsigned* bm = (LDSP unsigned*)(idl + 256);
    LDSP int* jsl = (LDSP int*)(bm + 8);
    LDSP unsigned* imp = (LDSP unsigned*)(lds + NSA_SB_OFF);
    LDSP u32x4* slcb = (LDSP u32x4*)(lds + NSA_SB_OFF) + wid * 512 + lane;
    const float kcm2 = ((gld(kb + 16 + kvh * 8 + 0) + gld(kb + 16 + kvh * 8 + 1)) + (gld(kb + 16 + kvh * 8 + 2) + gld(kb + 16 + kvh * 8 + 3))) + ((gld(kb + 16 + kvh * 8 + 4) + gld(kb + 16 + kvh * 8 + 5)) + (gld(kb + 16 + kvh * 8 + 6) + gld(kb + 16 + kvh * 8 + 7)));
    const float ksm2 = (gld(kb + kvh * 4 + 0) + gld(kb + kvh * 4 + 1)) + (gld(kb + kvh * 4 + 2) + gld(kb + kvh * 4 + 3));
    const float kwm2 = (gld(kb + 8 + kvh * 4 + 0) + gld(kb + 8 + kvh * 4 + 1)) + (gld(kb + 8 + kvh * 4 + 2) + gld(kb + 8 + kvh * 4 + 3));
    for (int i = tid; i < 32 * 257; i += 512) imp[i] = 0u;
    if (tid < 8) bm[tid] = 0u;
    const float NINF = -__builtin_inff();
    {
    const int ntiles = ((t0 >> 4) >> 6) + 1;
    const bf16_t* Kg = kcmp + (size_t)kvh * NCMPP * 128;
    const bf16_t* Vg = vcmpt + (size_t)kvh * 128 * NCMPP;
    float mH[2], lH[2]; int jsH[2]; LDSP int* jsl2 = jsl + 8;
    {
        bf16x8 qa[8], qb[8];
        load_q(qa, qkv + (size_t)t * NSWP + (kvh * 16 + wid) * 128 + 8 * h); load_q(qb, qkv + (size_t)t * NSWP + (kvh * 16 + 8 + wid) * 128 + 8 * h);
        const float slA = slope_l1(kvh, wid) * LOG2E, slB = slope_l1(kvh, 8 + wid) * LOG2E;
        auto bound = [&](const bf16x8 (&q)[8], float slope2, float& zbw, int& js) {
            float qn2 = 0.f;
#pragma unroll
            for (int d0 = 0; d0 < 8; ++d0)
#pragma unroll
                for (int e = 0; e < 8; ++e) { const float v = bf2f((bf16_t)q[d0][e]); qn2 += v * v; }
            qn2 += __shfl_xor(qn2, 32);
            zbw = sqrtf(qn2 * kcm2) * C2 * 1.001f + 0.5f;
#pragma unroll
            for (int o_ = 16; o_ >= 1; o_ >>= 1) zbw = fmaxf(zbw, __shfl_xor(zbw, o_));
            const float X = (float)(t0 - 1039) - (152.f + 2.f * zbw + 15.f * slope2) / slope2; js = X > 0.f ? (int)floorf(X * (1.0f / 1024.0f)) : 0; if (js > ntiles - 1) js = ntiles - 1;
            js = __builtin_amdgcn_readfirstlane(js); };
        float zbA, zbB; int jsA, jsB; bound(qa, slA, zbA, jsA); bound(qb, slB, zbB, jsB);
        const bool fastA = zbA <= ZB_FAST, fastB = zbB <= ZB_FAST;
        if (lane == 0) { jsl[wid] = min(jsA, jsB); jsl2[wid] = jsA; jsl2[8 + wid] = jsB; }
        float mA = -1e30f, lA = 0.f, mB = -1e30f, lB = 0.f; f32x2v laccA = {0.f, 0.f}, laccB = {0.f, 0.f};
        auto p1_step = [&](const bf16x8 (&q)[8], float slope2, bool fast, float& m, float& l, f32x2v& lacc, const LDSP char* kl, int j) {
            f32x16 p0, p1; qk_tile(p0, p1, kl, q, r, h);
            float mx = NINF;
            if (fast) { tile_scores<16, false>(p0, p1, slope2, t - 16 * (j * 64 + 16 * h) - 31, 0x7fffffffu, mx); exp_acc(p0, p1, lacc); } else {
            tile_scores<16>(p0, p1, slope2, t - 16 * (j * 64 + 16 * h) - 31, 0x7fffffffu, mx);
            mx = fmaxf(mx, __shfl_xor(mx, 32));
            const float mn = fmaxf(m, mx); f32x2v acc = {0.f, 0.f};
#pragma unroll
            for (int i = 0; i < 16; i += 2) { f32x2v a = {p0[i], p0[i + 1]}, b = {p1[i], p1[i + 1]}; a = a - mn; b = b - mn;
                a.x = ex2(a.x); a.y = ex2(a.y); b.x = ex2(b.x); b.y = ex2(b.y); acc += a; acc += b; }
            float ps = acc.x + acc.y; ps += __shfl_xor(ps, 32);
            l = l * ex2(m - mn) + ps; m = mn; } };
        TileRegs R; int buf = 0;
        __syncthreads();
        int jmin = jsl[0];
#pragma unroll
        for (int w = 1; w < 8; ++w) jmin = min(jmin, jsl[w]);
        g_load_k(R, Kg, 128, jmin * 64, tid); s_store_k(lds, R, tid);
        __syncthreads();
        for (int j = jmin; j < ntiles; ++j) {
            const LDSP char* kl = lds + buf * TB_BYTES;
            if (j + 1 < ntiles) g_load_k(R, Kg, 128, (j + 1) * 64, tid);
            if (j >= jsA) p1_step(qa, slA, fastA, mA, lA, laccA, kl, j);
            if (j >= jsB) p1_step(qb, slB, fastB, mB, lB, laccB, kl, j);
            if (j + 1 < ntiles) s_store_k(lds + (buf ^ 1) * TB_BYTES, R, tid);
            __syncthreads(); buf ^= 1;
        }
        if (fastA) { float ps = laccA.x + laccA.y; ps += __shfl_xor(ps, 32); lA = ps; mA = 0.f; }
        if (fastB) { float ps = laccB.x + laccB.y; ps += __shfl_xor(ps, 32); lB = ps; mB = 0.f; }
        mH[0] = mA; lH[0] = lA; jsH[0] = jsA; mH[1] = mB; lH[1] = lB; jsH[1] = jsB;
    }
    for (int hh = 0; hh < 2; ++hh) {
        const int g = 8 * hh + wid, hq = kvh * 16 + g;
        const float slope2 = slope_l1(kvh, g) * LOG2E;
        bf16x8 qr[8]; load_q(qr, qkv + (size_t)t * NSWP + hq * 128 + 8 * h);
        const float m = hh ? mH[1] : mH[0], l = hh ? lH[1] : lH[0]; const int js = hh ? jsH[1] : jsH[0];
        int jmin = jsl2[8 * hh];
#pragma unroll
        for (int w = 1; w < 8; ++w) jmin = min(jmin, jsl2[8 * hh + w]);
        TileRegs R; int buf = 0;
        const float linv = 1.f / fmaxf(l, 1e-30f);
        f32x16 o[4];
#pragma unroll
        for (int d0 = 0; d0 < 4; ++d0)
#pragma unroll
            for (int i = 0; i < 16; ++i) o[d0][i] = 0.f;
        buf = 0;
        g_load_k(R, Kg, 128, jmin * 64, tid); g_load_v(R, Vg, NCMPP, jmin * 64, tid); s_store_k(lds, R, tid); s_store_v(lds + KT_BYTES, R, tid);
        __syncthreads();
        for (int j = jmin; j < ntiles; ++j) {
            const LDSP char* kl = lds + buf * TB_BYTES; const LDSP char* vl = kl + KT_BYTES;
            if (j + 1 < ntiles) { g_load_k(R, Kg, 128, (j + 1) * 64, tid); g_load_v(R, Vg, NCMPP, (j + 1) * 64, tid); }
            if (j >= js) {
            f32x16 p0, p1; qk_tile(p0, p1, kl, qr, r, h);
            float mx = 0.f; tile_scores<16, false>(p0, p1, slope2, t - 16 * (j * 64 + 16 * h) - 31, 0x7fffffffu, mx, m);
#pragma unroll
            for (int i = 0; i < 16; i += 2) { f32x2v a = {p0[i], p0[i + 1]}, b = {p1[i], p1[i + 1]};
                a.x = ex2(a.x); a.y = ex2(a.y); b.x = ex2(b.x); b.y = ex2(b.y); a = a * linv; b = b * linv;
                p0[i] = a.x; p0[i + 1] = a.y; p1[i] = b.x; p1[i + 1] = b.y; }
            LDSP unsigned* ir = imp + r * 257 + 16 * j + 4 * h;
#pragma unroll
            for (int q4 = 0; q4 < 4; ++q4) {
                const float s0 = (p0[4 * q4] + p0[4 * q4 + 1]) + (p0[4 * q4 + 2] + p0[4 * q4 + 3]);
                const float s1 = (p1[4 * q4] + p1[4 * q4 + 1]) + (p1[4 * q4 + 2] + p1[4 * q4 + 3]);
                LADD(ir + q4, (unsigned)(s0 * 16777216.f + 0.5f));
                LADD(ir + q4 + 1, (unsigned)(p0[4 * q4 + 3] * 16777216.f + 0.5f));
                LADD(ir + 8 + q4, (unsigned)(s1 * 16777216.f + 0.5f));
                LADD(ir + 8 + q4 + 1, (unsigned)(p1[4 * q4 + 3] * 16777216.f + 0.5f)); }
            pv_tile(o, p0, p1, vl, r, h);
            }
            if (j + 1 < ntiles) { s_store_k(lds + (buf ^ 1) * TB_BYTES, R, tid); s_store_v(lds + (buf ^ 1) * TB_BYTES + KT_BYTES, R, tid); }
            __syncthreads(); buf ^= 1;
        }
        const float gate = sigmoidf_(bf2f(gld(qkv + ((size_t)t * NSWP + 5632 + kvh * 48 + g * 3 + 0))));
        bf16_t* op = ob + (size_t)t * DM + hq * 128 + 4 * h;
#pragma unroll
        for (int d0 = 0; d0 < 4; ++d0)
#pragma unroll
            for (int gq = 0; gq < 4; ++gq) { u32x2 w; w.x = pk2(o[d0][4 * gq] * gate, o[d0][4 * gq + 1] * gate); w.y = pk2(o[d0][4 * gq + 2] * gate, o[d0][4 * gq + 3] * gate);
                gst((u32x2*)(op + 32 * d0 + 8 * gq), (u32x2)(w)); }
    }
    }
    __syncthreads();
    {
        const int qq = lane >> 4, sub = lane & 15, rq = wid * 4 + qq, cur = (t0 + rq) >> 6;
        int sc[16];
#pragma unroll
        for (int e = 0; e < 16; ++e) { const int j = sub + 16 * e; const bool valid = j <= cur, forced = (j == 0) || (j == cur) || (j == cur - 1);
            sc[e] = valid ? (int)(imp[rq * 257 + j] + (forced ? (1u << 30) : 0u) + 1u) : 0; }
        for (int rd = 0; rd < 8; ++rd) {
            int bs = sc[0], bj = sub;
#pragma unroll
            for (int e = 1; e < 16; ++e) { const bool tk = sc[e] > bs; bs = tk ? sc[e] : bs; bj = tk ? sub + 16 * e : bj; }
#pragma unroll
            for (int o_ = 1; o_ <= 8; o_ <<= 1) { const int os = __shfl_xor(bs, o_), oj = __shfl_xor(bj, o_); const bool tk = (os > bs) || (os == bs && oj < bj); bs = tk ? os : bs; bj = tk ? oj : bj; }
            if (sub == 0) idl[rq * 8 + rd] = bj;
#pragma unroll
            for (int e = 0; e < 16; ++e) sc[e] = (bj == sub + 16 * e) ? -1 : sc[e];
        }
    }
    __syncthreads();
    if (tid < 256) { const int b = idl[tid]; if (b * 64 <= t0 + 31) (void)__hip_atomic_fetch_or(bm + (b >> 5), 1u << (b & 31), __ATOMIC_RELAXED, __HIP_MEMORY_SCOPE_WORKGROUP); }
    unsigned s_lo = 0u, s_hi = 0u;
#pragma unroll
    for (int e = 0; e < 4; ++e) { s_lo |= (unsigned)idl[r * 8 + e] << (8 * e); s_hi |= (unsigned)idl[r * 8 + 4 + e] << (8 * e); }
    __syncthreads();
    for (int hh = 0; hh < 2; ++hh) {
        const int g = 8 * hh + wid, hq = kvh * 16 + g;
        const float slope2 = slope_l1(kvh, g) * LOG2E;
        bf16x8 qr[8]; load_q(qr, qkv + (size_t)t * NSWP + hq * 128 + 8 * h);
        float qn = 0.f;
#pragma unroll
        for (int d0 = 0; d0 < 8; ++d0)
#pragma unroll
            for (int e = 0; e < 8; ++e) { const float v = bf2f((bf16_t)qr[d0][e]); qn += v * v; }
        qn += __shfl_xor(qn, 32);
#pragma unroll
        for (int o_ = 16; o_ >= 1; o_ >>= 1) qn = fmaxf(qn, __shfl_xor(qn, o_));
        const float zbs = sqrtf(qn * ksm2) * C2 * 1.001f + 0.5f, zbw_ = sqrtf(qn * kwm2) * C2 * 1.001f + 0.5f;
        const float zs2 = 2.f * zbs + 152.f, zw2 = 2.f * zbw_ + 152.f;
        const bool fasts = zbs <= ZB_FAST, fastw = zbw_ <= ZB_FAST;
        {
            const bf16_t* Kg = qkv + 4608 + kvh * 128; const bf16_t* Vg = vts + (size_t)kvh * 128 * S;
            float m = -1e30f, l = 0.f; f32x16 o[4];
#pragma unroll
            for (int d0 = 0; d0 < 4; ++d0)
#pragma unroll
                for (int i = 0; i < 16; ++i) o[d0][i] = 0.f;
            struct Seq { const LDSP unsigned* bm; __device__ int first() const { return prev_bit(bm, 255); } __device__ int next(int t_) const { return prev_bit(bm, t_ - 1); } __device__ int base(int t_) const { return t_ * 64; } } seq{bm};
            auto score = [&](f32x16& p0, f32x16& p1, int b, float& mx) {
                const unsigned bb = (unsigned)b * 0x01010101u, x0 = s_lo ^ bb, x1 = s_hi ^ bb;
                const bool selq = (((x0 - 0x01010101u) & ~x0 & 0x80808080u) | ((x1 - 0x01010101u) & ~x1 & 0x80808080u)) != 0u;
                if (!__any(selq)) return false;
                if (slope2 * (float)(t0 - b * 64 - 63) > zs2) return false;
                if (fasts) tile_scores<1, false>(p0, p1, slope2, t - b * 64 - 16 * h, selq ? 0x7fffffffu : 0u, mx);
                else tile_scores<1>(p0, p1, slope2, t - b * 64 - 16 * h, selq ? 0x7fffffffu : 0u, mx);
                return true; };
            attn_stream(seq, score, Kg, (size_t)NSWP, Vg, (size_t)S, qr, m, l, o, lds, tid, r, h, wid >= 4, fasts);
            const float f = sigmoidf_(bf2f(gld(qkv + ((size_t)t * NSWP + 5632 + kvh * 48 + g * 3 + 1)))) / l;
#pragma unroll
            for (int d0 = 0; d0 < 4; ++d0)
#pragma unroll
                for (int g2 = 0; g2 < 2; ++g2) { u32x4 w;
                    w.x = pk2(o[d0][8 * g2] * f, o[d0][8 * g2 + 1] * f); w.y = pk2(o[d0][8 * g2 + 2] * f, o[d0][8 * g2 + 3] * f);
                    w.z = pk2(o[d0][8 * g2 + 4] * f, o[d0][8 * g2 + 5] * f); w.w = pk2(o[d0][8 * g2 + 6] * f, o[d0][8 * g2 + 7] * f);
                    slcb[(d0 * 2 + g2) * 64] = w; }
        }
        {
            const bf16_t* Kg = qkv + 5120 + kvh * 128; const bf16_t* Vg = vtw + (size_t)kvh * 128 * S;
            float m = -1e30f, l = 0.f; f32x16 o[4];
#pragma unroll
            for (int d0 = 0; d0 < 4; ++d0)
#pragma unroll
                for (int i = 0; i < 16; ++i) o[d0][i] = 0.f;
            int lowk = t0 - 511; if (lowk < 0) lowk = 0;
            const int jlo = lowk >> 6, jhi = (t0 + 31) >> 6;
            struct Seq { int lo, hi; __device__ int first() const { return hi; } __device__ int next(int t_) const { return t_ > lo ? t_ - 1 : -1; } __device__ int base(int t_) const { return t_ * 64; } } seq{jlo, jhi};
            auto score = [&](f32x16& p0, f32x16& p1, int j, float& mx) {
                if (slope2 * (float)(t0 - j * 64 - 63) > zw2) return false;
                if (fastw) tile_scores<1, false>(p0, p1, slope2, t - j * 64 - 16 * h, 512u, mx);
                else tile_scores<1>(p0, p1, slope2, t - j * 64 - 16 * h, 512u, mx);
                return true; };
            attn_stream(seq, score, Kg, (size_t)NSWP, Vg, (size_t)S, qr, m, l, o, lds, tid, r, h, wid >= 4, fastw);
            const float f = sigmoidf_(bf2f(gld(qkv + ((size_t)t * NSWP + 5632 + kvh * 48 + g * 3 + 2)))) / l;
            bf16_t* op = ob + (size_t)t * DM + hq * 128 + 4 * h;
#pragma unroll
            for (int d0 = 0; d0 < 4; ++d0)
#pragma unroll
                for (int g2 = 0; g2 < 2; ++g2) { const u32x4 b = slcb[(d0 * 2 + g2) * 64];
#pragma unroll
                    for (int q2 = 0; q2 < 2; ++q2) { const int gq = 2 * g2 + q2; const u32x2 a = gld((const u32x2*)(op + 32 * d0 + 8 * gq)); const unsigned b0 = b[2 * q2], b1 = b[2 * q2 + 1];
                        u32x2 w; w.x = pk2((__uint_as_float(a.x << 16) + __uint_as_float(b0 << 16)) + o[d0][4 * gq] * f, (__uint_as_float(a.x & 0xffff0000u) + __uint_as_float(b0 & 0xffff0000u)) + o[d0][4 * gq + 1] * f);
                        w.y = pk2((__uint_as_float(a.y << 16) + __uint_as_float(b1 << 16)) + o[d0][4 * gq + 2] * f, (__uint_as_float(a.y & 0xffff0000u) + __uint_as_float(b1 & 0xffff0000u)) + o[d0][4 * gq + 3] * f);
                        gst((u32x2*)(op + 32 * d0 + 8 * gq), (u32x2)(w)); } }
        }
    }
    __syncthreads();
}

__device__ __forceinline__ void posb_compute(const float* pos, const float* w1, float* posb, int jg, LDSP char* lds) {
    LDSP float* red = (LDSP float*)lds;
    const int tid = tid_l(), jj = tid & 7, sp = tid >> 3; float a = 0.f;
#pragma unroll 8
    for (int k = sp * 64; k < sp * 64 + 64; ++k) a += gld(pos + k) * gld(w1 + (size_t)k * 128 + 8 * jg + jj);
    red[sp * 8 + jj] = a; __syncthreads();
    if (tid < 8) { float s = 0.f; for (int q = 0; q < 64; ++q) s += red[q * 8 + tid]; gst(posb + 8 * jg + tid, s); }
    __syncthreads();
}
__device__ __forceinline__ void cmp_mlp_unit2(const bf16_t* qkv, const bf16_t* w1t, const bf16_t* w2t, const float* posb, bf16_t* kcmp, bf16_t* vcmpt, unsigned* kpc, int which, int kvh, int grp, LDSP char* lds) {
    LDSP bf16_t* gl = (LDSP bf16_t*)(lds + 81920);
    const int tid = tid_l(), wid = __builtin_amdgcn_readfirstlane(tid >> 6), lane = tid & 63, nl = lane & 15, quad = lane >> 4;
    const int c0 = grp * 16, scol = (which ? 4352 : 4096) + kvh * 128;
    for (int q = tid; q < 272 * 16; q += 512) { const int R = q >> 4, ch = q & 15; int gr = 16 * c0 + R; gr = gr < S ? gr : S - 1;
        *(LDSP u32x4*)(lds + ((R & 15) * 17 + (R >> 4)) * 272 + ch * 16) = gld((const u32x4*)(qkv + (size_t)gr * NSWP + scol + ch * 8)); }
    __syncthreads();
    const bf16_t* bp = w1t + (size_t)(16 * wid + nl) * 4096 + 8 * quad;
    f32x4 acc = {0.f, 0.f, 0.f, 0.f};
    for (int ks0 = 0; ks0 < 128; ks0 += 16) {
        bf16x8 b[16];
#pragma unroll
        for (int u = 0; u < 16; ++u) b[u] = gld((const bf16x8*)(bp + 32 * (ks0 + u)));
#pragma unroll
        for (int u = 0; u < 16; ++u) { const int ks = ks0 + u, ro = ks >> 2;
            const bf16x8 a = *(const LDSP bf16x8*)(lds + ((ro & 15) * 17 + nl + (ro >> 4)) * 272 + ((ks & 3) * 32 + 8 * quad) * 2);
            acc = MFMA16(a, b[u], acc); }
    }
    { const float pb = gld(posb + 16 * wid + nl);
#pragma unroll
      for (int i = 0; i < 4; ++i) gl[(4 * quad + i) * 136 + 16 * wid + nl] = (bf16_t)(pk2(gelu_tanh(acc[i] + pb), 0.f) & 0xffffu); }
    __syncthreads();
    f32x4 acc2 = {0.f, 0.f, 0.f, 0.f};
#pragma unroll
    for (int js = 0; js < 4; ++js) { const bf16x8 a = *(const LDSP bf16x8*)(gl + nl * 136 + 32 * js + 8 * quad);
        const bf16x8 b = gld((const bf16x8*)(w2t + (size_t)(16 * wid + nl) * 128 + 32 * js + 8 * quad));
        acc2 = MFMA16(a, b, acc2); }
    const int n2 = 16 * wid + nl;
#pragma unroll
    for (int i = 0; i < 4; ++i) if (c0 + 4 * quad + i >= NCMP) acc2[i] = 0.f;
    if (which == 0) {
        float kmx = 0.f;
#pragma unroll
        for (int i = 0; i < 4; ++i) { const unsigned w = pk2(acc2[i], 0.f) & 0xffffu; gst(kcmp + ((size_t)kvh * NCMPP + c0 + 4 * quad + i) * 128 + n2, (bf16_t)w);
            float ss = __uint_as_float(w << 16); ss *= ss;
#pragma unroll
            for (int o_ = 1; o_ <= 8; o_ <<= 1) ss += __shfl_xor(ss, o_);
            kmx = fmaxf(kmx, ss); }
        kmx = fmaxf(kmx, __shfl_xor(kmx, 16)); kmx = fmaxf(kmx, __shfl_xor(kmx, 32));
        if (lane == 0) atomicMax(kpc + kvh * 8 + wid, __float_as_uint(kmx));
    } else { u32x2 w; w.x = pk2(acc2[0], acc2[1]); w.y = pk2(acc2[2], acc2[3]); gst((u32x2*)(vcmpt + ((size_t)kvh * 128 + n2) * NCMPP + c0 + 4 * quad), (u32x2)(w)); }
    __syncthreads();
}
struct Ptrs {
    const float *x, *attn_norm, *ffn_norm, *w_gate_up, *w_down, *ab_w_in, *ab_sinks, *ab_w_out, *nsa_w_in, *cmp_pos, *wk1, *wk2, *wv1, *wv2, *nsa_w_out, *final_norm;
    float* out; char* ws;
};
#define WSP(T, off) ((T*)(p.ws + (off)))
constexpr size_t OFF_W1TK = OFF_SCR, OFF_W1TV = OFF_W1TK + 128 * 4096 * 2, OFF_W2TK = OFF_W1TV + 128 * 4096 * 2, OFF_W2TV = OFF_W2TK + 128 * 128 * 2, OFF_POSB = OFF_W2TV + 128 * 128 * 2;
constexpr size_t OFF_KMAX = 14336;
constexpr size_t OFF_OSLC = OFF_HID;
__device__ __forceinline__ void attn_l0_phase(const Ptrs& p, LDSP char* lds, int bid, int nb) {
    const bf16_t* qkv = WSP(const bf16_t, OFF_QKV); bf16_t* ob = WSP(bf16_t, OFF_OB);
    const int wid = __builtin_amdgcn_readfirstlane(tid_l() >> 6);
    for (int u = bid; u < 512 + 1536; u += nb) {
        if (u < 512) { const int head = u & 7, qb = 63 - (u >> 3); sb_unit(qkv, WSP(const bf16_t, OFF_VTA), ob, WSP(const float, OFF_KMAX), head, qb, lds); }
        else { const int v = u - 512, kvh = v % 3, qt = v / 3; const int hq = kvh * 8 + wid;
            win_unit<128, true, false>(qkv, ABW, 3072 + hq * 128, 6144 + kvh * 128, WSP(const bf16_t, OFF_VTB) + (size_t)kvh * 128 * S, slope_l0(kvh, wid), gld(p.ab_sinks + hq), 1.f,
                                       (const float*)nullptr, (const float*)nullptr, ob, 1024 + hq * 128, qt, lds); }
    }
}
__device__ __forceinline__ void cmp_mlp_phase(const Ptrs& p, LDSP char* lds, int bid, int nb) {
    for (int u = bid; u < 256; u += nb) { const int which = u & 1, kvh = (u >> 1) & 1, grp = u >> 2;
        cmp_mlp_unit2(WSP(const bf16_t, OFF_QKV), which ? WSP(const bf16_t, OFF_W1TV) : WSP(const bf16_t, OFF_W1TK), which ? WSP(const bf16_t, OFF_W2TV) : WSP(const bf16_t, OFF_W2TK),
                      WSP(const float, OFF_POSB) + which * 128, WSP(bf16_t, OFF_KCMP), WSP(bf16_t, OFF_VCMPT), WSP(unsigned, OFF_KMAX) + 48, which, kvh, grp, lds); }
}
__device__ __forceinline__ void nsa_phase(const Ptrs& p, LDSP char* lds, int bid, int nb) {
    const int lb = (nb == 256) ? ((bid & 7) * 32 + (bid >> 3)) : bid;
    for (int u = lb; u < 1024; u += nb) { const int kvh = u & 1, b_ = (u & 255) >> 1, i_ = u >> 8; const int qt = i_ == 0 ? 511 - b_ : i_ == 1 ? 256 + b_ : i_ == 2 ? 255 - b_ : b_;
        nsa_unit(WSP(const bf16_t, OFF_QKV), WSP(const bf16_t, OFF_KCMP), WSP(const bf16_t, OFF_VCMPT), WSP(const bf16_t, OFF_VTS), WSP(const bf16_t, OFF_VTW), WSP(const float, OFF_KMAX) + 32, WSP(bf16_t, OFF_OB), kvh, qt, lds); }
}
template <class Epi> __device__ __forceinline__ void gemm_call(LDSP char* lds, const bf16_t* A, const bf16_t* Bt, int M, int N, int K, int tiled, const Epi& E, int bid, int nb) {
    pg8::Gemm g{A, Bt, M, N, K, tiled}; pg8::StaticOrder So; So.init(M, N, nb, bid);
    pg8::gemm_phase<Epi, pg8::StaticOrder, false>((PG8_LAS unsigned char*)lds, g, So, E, nullptr);
}

constexpr int LDS_GEMM = pg8::STAGE_BYTES;
constexpr int LDS_ST = NSA_SB_OFF + 65536;
constexpr int LDS_TOTAL = LDS_ST + 16;
static_assert(XCD_BAR_WORDS * 4 <= OFF_KMAX && NSA_SB_OFF + 32 * 257 * 4 <= LDS_GEMM && LDS_GEMM <= LDS_ST && LDS_TOTAL <= 163840 && (144 * 128 + 4 * 9 * 128 + 8 * 128) * 4 <= LDS_GEMM, "LDS");
extern __shared__ __attribute__((aligned(16))) unsigned char dyn_lds[];
#ifndef DUP_MASK
#define DUP_MASK 0
#endif
#define REP(k, ...) do { _Pragma("nounroll") for (int rep_ = 0; rep_ < 1 + ((DUP_MASK >> (k)) & 1); ++rep_) { __VA_ARGS__; } } while (0)
#ifndef PROBE_BLK
#define PROBE_BLK 0
#endif
#ifndef PROBE_T
#define PROBE_T 0
#endif
#define TIMEIT(bit, ...) do { if (PROBE_T & (bit)) { const unsigned long long t0_ = wall_clock64(); __VA_ARGS__; tacc += wall_clock64() - t0_; } else { __VA_ARGS__; } } while (0)
#define GBAR() TIMEIT(1, xcd_barrier(bar))
struct MkArgs { Ptrs p; CvtJobs js; unsigned* bar; };
__global__ __launch_bounds__(512, 2) void k_mega(MkArgs a) {
    LDSP char* lds = (LDSP char*)dyn_lds;
    volatile LAS unsigned* st = (volatile LAS unsigned*)(lds + LDS_ST);
    if (threadIdx.x < 4) st[threadIdx.x] = 0u;
    __syncthreads();
    XcdBarrier bar = xcd_barrier_post(a.bar, st);
    unsigned long long tacc = 0ull;
    if (blockIdx.x >= 64 && blockIdx.x < 96) { const int wh = blockIdx.x & 1, jg = (blockIdx.x - 64) >> 1; posb_compute(a.p.cmp_pos, wh ? a.p.wv1 : a.p.wk1, (float*)(a.p.ws + OFF_POSB) + wh * 128, jg, lds); }
    TIMEIT(2, REP(0, cvt_phase(a.js, lds, (int)blockIdx.x, (int)gridDim.x)));
#pragma nounroll
    for (int layer = 0; layer < 2; ++layer) {
        int bid = (int)blockIdx.x, nb = (int)gridDim.x; Ptrs p = a.p;
        asm volatile("" : "+s"(bid), "+s"(nb), "+s"(p.ws));
        bf16_t *hb = WSP(bf16_t, OFF_HB), *ob = WSP(bf16_t, OFF_OB), *qkv = WSP(bf16_t, OFF_QKV), *hid = WSP(bf16_t, OFF_HID);
        bf16_t *x1 = WSP(bf16_t, OFF_X1), *x2 = WSP(bf16_t, OFF_X2);
        if (layer == 0) { TIMEIT(16, REP(1, rmsnorm_phase<false, false, true>(p.x, p.attn_norm, hb, (float*)nullptr, x2, bid, nb))); }
        else { TIMEIT(16, REP(1, rmsnorm_phase<false, true, false>(x2, p.attn_norm + DM, hb, (float*)nullptr, (bf16_t*)nullptr, bid, nb))); }
        GBAR();
        {
            const EpiBf16 E0{qkv, WSP(bf16_t, OFF_VTA), WSP(bf16_t, OFF_VTB), WSP(unsigned, OFF_KMAX), (unsigned*)nullptr, ABW, 2048, 3072, 6528, 6912, 1024, 2048, 0, 0, 0};
            const EpiBf16 E1{qkv, WSP(bf16_t, OFF_VTS), WSP(bf16_t, OFF_VTW), WSP(unsigned, OFF_KMAX) + 32, WSP(unsigned, OFF_KMAX) + 40, NSWP, 4864, 5120, 5376, 5632, 4608, 4864, 5120, 5376, 0};
            TIMEIT(4 | 32, gemm_call(lds, hb, layer ? WSP(const bf16_t, OFF_WT_NSIN) : WSP(const bf16_t, OFF_WT_ABIN), S, layer ? NSWP : ABW, DM, 0, layer ? E1 : E0, bid, nb)); }
        GBAR();
        if (layer == 0) {
            TIMEIT(8, REP(2, attn_l0_phase(p, lds, bid, nb)));
        } else {
            TIMEIT(16 | 512, REP(3, cmp_mlp_phase(p, lds, bid, nb)));
            GBAR();
            TIMEIT(8, REP(4, nsa_phase(p, lds, bid, nb)));
        }
        GBAR();
        TIMEIT(4 | 64, REP(9, gemm_call(lds, ob, layer ? WSP(const bf16_t, OFF_WT_NSOUT) : WSP(const bf16_t, OFF_WT_ABOUT), S, DM, DM, 0, EpiRes{x2, x1, DM, 0}, bid, nb)));
        GBAR();
        TIMEIT(16, REP(1, rmsnorm_phase<false, true, false>(x1, p.ffn_norm + layer * DM, hb, (float*)nullptr, (bf16_t*)nullptr, bid, nb)));
        GBAR();
        TIMEIT(4 | 128, REP(10, gemm_call(lds, hb, layer ? WSP(const bf16_t, OFF_WT_GU1) : WSP(const bf16_t, OFF_WT_GU0), S, 2 * DFF, DM, 0, EpiSwiGLU{hid, DFF, 1}, bid, nb)));
        GBAR();
        TIMEIT(4 | 256, REP(11, gemm_call(lds, hid, layer ? WSP(const bf16_t, OFF_WT_DN1) : WSP(const bf16_t, OFF_WT_DN0), S, DM, DFF, 3, EpiRes{x1, x2, DM, 0}, bid, nb)));
        GBAR();
    }
    { const Ptrs& p = a.p;
      rmsnorm_phase<true, true, false>(WSP(const bf16_t, OFF_X2), p.final_norm, (bf16_t*)nullptr, p.out, (bf16_t*)nullptr, (int)blockIdx.x, (int)gridDim.x); }
    if (PROBE_T && blockIdx.x == PROBE_BLK) { const unsigned long long t0_ = wall_clock64(); while (wall_clock64() - t0_ < tacc) __builtin_amdgcn_s_sleep(8); }
}
extern "C" void kernel_launch(void* const* d_in, const int* in_sizes, int n_in, void* d_out, int out_size, void* d_ws, size_t ws_size, hipStream_t stream) {
    (void)in_sizes; (void)out_size;
    if (n_in != 16 || ws_size < WS_NEED) { fprintf(stderr, "kernel_launch: bad arguments (n_in %d, ws %zu, need %zu)\n", n_in, ws_size, (size_t)WS_NEED); return; }
    static int grid = 0;
    if (!grid) { int dev = 0, cus = 0, per_cu = 0; (void)hipGetDevice(&dev);
        if (hipDeviceGetAttribute(&cus, hipDeviceAttributeMultiprocessorCount, dev) != hipSuccess || cus <= 0) cus = 256;
        hipError_t e = hipFuncSetAttribute((const void*)k_mega, hipFuncAttributeMaxDynamicSharedMemorySize, LDS_TOTAL);
        if (e != hipSuccess) fprintf(stderr, "hipFuncSetAttribute: %s\n", hipGetErrorString(e));
        if (hipOccupancyMaxActiveBlocksPerMultiprocessor(&per_cu, (const void*)k_mega, 512, LDS_TOTAL) != hipSuccess || per_cu < 1) { fprintf(stderr, "occupancy query failed (%d)\n", per_cu); per_cu = 1; }
        grid = cus * 1; }
    MkArgs a{};
    Ptrs& p = a.p;
    p.x = (const float*)d_in[0]; p.attn_norm = (const float*)d_in[1]; p.ffn_norm = (const float*)d_in[2]; p.w_gate_up = (const float*)d_in[3]; p.w_down = (const float*)d_in[4];
    p.ab_w_in = (const float*)d_in[5]; p.ab_sinks = (const float*)d_in[6]; p.ab_w_out = (const float*)d_in[7]; p.nsa_w_in = (const float*)d_in[8]; p.cmp_pos = (const float*)d_in[9];
    p.wk1 = (const float*)d_in[10]; p.wk2 = (const float*)d_in[11]; p.wv1 = (const float*)d_in[12]; p.wv2 = (const float*)d_in[13]; p.nsa_w_out = (const float*)d_in[14]; p.final_norm = (const float*)d_in[15];
    p.out = (float*)d_out; p.ws = (char*)d_ws;
    { const float* srcs[NCVT] = {p.ab_w_in, p.ab_w_out, p.w_gate_up, p.w_gate_up + (size_t)DM * 2 * DFF, p.w_down, p.w_down + (size_t)DFF * DM, p.nsa_w_in, p.nsa_w_out, p.wk1, p.wv1, p.wk2, p.wv2};
      const size_t offs[NCVT] = {OFF_WT_ABIN, OFF_WT_ABOUT, OFF_WT_GU0, OFF_WT_GU1, OFF_WT_DN0, OFF_WT_DN1, OFF_WT_NSIN, OFF_WT_NSOUT, OFF_W1TK, OFF_W1TV, OFF_W2TK, OFF_W2TV};
      const int Ks[NCVT] = {DM, DM, DM, DM, DFF, DFF, DM, DM, 4096, 4096, 128, 128}, Ns[NCVT] = {ABW, DM, 2 * DFF, 2 * DFF, DM, DM, NSW, DM, 128, 128, 128, 128}, No[NCVT] = {ABW, DM, 2 * DFF, 2 * DFF, DM, DM, NSWP, DM, 128, 128, 128, 128}, md[NCVT] = {0, 0, 1, 1, 2, 2, 0, 0, 0, 0, 0, 0};
      int t0 = 0; for (int i = 0; i < NCVT; ++i) { a.js.j[i] = CvtJob{srcs[i], (bf16_t*)(p.ws + offs[i]), Ks[i], Ns[i], No[i], md[i], t0, No[i] / 64}; t0 += (No[i] / 64) * (Ks[i] / 64); } a.js.total = t0; }
    a.bar = (unsigned*)(p.ws + OFF_BAR);
    (void)hipMemsetAsync(a.bar, 0, 16384, stream);
    hipLaunchKernelGGL(k_mega, dim3(grid), dim3(512), LDS_TOTAL, stream, a);
}
```
